# Optimizing an MI355X kernel written in HIP

```python
import math
import jax
import jax.numpy as jnp
from jax import lax
import numpy as np

D_MODEL = 1024
BATCH = 4
SEQ = 8192
DEPTH = 2

NSA_HEADS = 8
NSA_GROUPS = 2
NSA_HPG = NSA_HEADS // NSA_GROUPS
HEAD_DIM = 64
NSA_WIDTH = NSA_HEADS * HEAD_DIM
NSA_KV = NSA_GROUPS * HEAD_DIM
CMP_STRIDE = 16
CMP_LEN = 2 * CMP_STRIDE
CMP_HIDDEN = 256
SEL_BLOCK = 64
SEL_TOPN = 16
WINDOW = 512
Q_BLOCK = 128
SEL_FORCE = 1e9

RWKV_HEADS = 8
RWKV_HEAD = 64
RWKV_WIDTH = RWKV_HEADS * RWKV_HEAD
LORA_W = 64
LORA_A = 64
LORA_V = 32
LORA_G = 128
GN_EPS = 64e-5

REL_BUCKETS = 32
REL_MAX_DIST = 1024

MEM_LEN = 256
XATTN_HEADS = 4
XATTN_HEAD = 128
XATTN_WIDTH = XATTN_HEADS * XATTN_HEAD

N_EXPERTS = 16
N_EXPERT_GROUPS = 4
EXPERTS_PER_GROUP = N_EXPERTS // N_EXPERT_GROUPS
TOP_K = 2
EXPERT_FF = 512
MOE_BLOCK = 128

DN_ALPHA = (2 * DEPTH) ** 0.25
DN_BETA = (8 * DEPTH) ** -0.25
LN_EPS = 1e-5
NEG_INF = -1e30

NSA_COLS = NSA_WIDTH + 6 * NSA_KV + 3 * NSA_HEADS
RWKV_COLS = 3 * RWKV_WIDTH + LORA_W + LORA_A + LORA_G
GATE_COLS = 2 * D_MODEL
IN_COLS = NSA_COLS + RWKV_COLS + GATE_COLS

kernel_name = 'hybrid_nsa_rwkv7_grouped_moe_deepnorm'


def _split(z, sizes):
    return jnp.split(z, np.cumsum(sizes)[:-1].tolist(), axis=-1)


def layer_norm(x, g, b):
    xf = x.astype(jnp.float32)
    mu = jnp.mean(xf, axis=-1, keepdims=True)
    var = jnp.mean(jnp.square(xf - mu), axis=-1, keepdims=True)
    return ((xf - mu) * lax.rsqrt(var + LN_EPS) * g + b).astype(x.dtype)


def masked_softmax(s, mask):
    s = jnp.where(mask, s.astype(jnp.float32), NEG_INF)
    m = jnp.max(s, axis=-1, keepdims=True)
    p = jnp.where(mask, jnp.exp(s - m), 0.0)
    return p / jnp.maximum(jnp.sum(p, axis=-1, keepdims=True), 1e-30)


def t5_bucket(dist):
    n = jnp.maximum(dist, 0)
    max_exact = REL_BUCKETS // 2
    log_ratio = jnp.log(jnp.maximum(n, 1).astype(jnp.float32) / max_exact) / math.log(REL_MAX_DIST / max_exact)
    large = jnp.minimum(max_exact + (log_ratio * (REL_BUCKETS - max_exact)).astype(jnp.int32), REL_BUCKETS - 1)
    return jnp.where(n < max_exact, n, large)


def token_shift_mix(z, mu):
    z_prev = jnp.pad(z[:, :-1], ((0, 0), (1, 0), (0, 0)))
    return z + mu * (z_prev - z)


def _compress(z, pe, w1, w2):
    B, T, G, dh = z.shape
    n_cmp = T // CMP_STRIDE - 1
    ch = z.reshape(B, T // CMP_STRIDE, CMP_STRIDE, G, dh)
    blocks = jnp.concatenate([ch[:, :-1], ch[:, 1:]], axis=2) + pe[:, None, :]
    flat = jnp.moveaxis(blocks, 3, 2).reshape(B, n_cmp, G, CMP_LEN * dh)
    return jax.nn.gelu(flat @ w1) @ w2


def _gather_blocks(blocks, idx):
    return jax.vmap(jax.vmap(lambda b, i: b[i]))(blocks, idx)


def nsa_attention(q, kc, vc, ks, vs, kw, vw, gate_logits, rel_table, pe_k, pe_v, w1k, w2k, w1v, w2v):
    B, T, _ = q.shape
    G, Hg, dh = NSA_GROUPS, NSA_HPG, HEAD_DIM
    scale = HEAD_DIM ** -0.5
    f32 = jnp.float32
    q = q.reshape(B, T, G, Hg, dh)
    kv = lambda z: z.reshape(B, T, G, dh)
    k_cmp = _compress(kv(kc), pe_k, w1k, w2k)
    v_cmp = _compress(kv(vc), pe_v, w1v, w2v)
    n_cmp = k_cmp.shape[1]
    n_sel = T // SEL_BLOCK
    n_top = min(SEL_TOPN, n_sel)
    k_blk = kv(ks).reshape(B, n_sel, SEL_BLOCK, G, dh).transpose(0, 3, 1, 2, 4)
    v_blk = kv(vs).reshape(B, n_sel, SEL_BLOCK, G, dh).transpose(0, 3, 1, 2, 4)
    pad = ((0, 0), (WINDOW, 0), (0, 0), (0, 0))
    k_win = jnp.pad(kv(kw), pad)
    v_win = jnp.pad(kv(vw), pad)
    gates = jax.nn.sigmoid(gate_logits.astype(f32)).reshape(B, T, G, Hg, 3)
    cmp_start = jnp.arange(n_cmp) * CMP_STRIDE
    cmp_end = cmp_start + CMP_LEN - 1
    sel_start = jnp.arange(n_sel) * SEL_BLOCK
    overlap = ((cmp_start[:, None] <= sel_start[None, :] + SEL_BLOCK - 1)
               & (cmp_end[:, None] >= sel_start[None, :])).astype(f32)
    tbl_g = rel_table.reshape(REL_BUCKETS, G, Hg).transpose(1, 0, 2).astype(f32)

    def bias_2d(dist):
        return rel_table[t5_bucket(dist)].reshape(dist.shape + (G, Hg)).transpose(2, 3, 0, 1).astype(f32)

    def block(c):
        t0 = c * Q_BLOCK
        tq = t0 + jnp.arange(Q_BLOCK)
        qc = lax.dynamic_slice_in_dim(q, t0, Q_BLOCK, axis=1)
        gc = lax.dynamic_slice_in_dim(gates, t0, Q_BLOCK, axis=1)
        mask_c = cmp_end[None, :] <= tq[:, None]
        s_c = jnp.einsum('bqghd,bngd->bghqn', qc, k_cmp).astype(f32) * scale + bias_2d(tq[:, None] - cmp_end[None, :])
        p_c = masked_softmax(s_c, mask_c)
        o_c = jnp.einsum('bghqn,bngd->bqghd', p_c, v_cmp.astype(f32))
        imp = jnp.einsum('bghqn,nj->bgqj', p_c, overlap)
        jq = tq // SEL_BLOCK
        jb = jnp.arange(n_sel)
        valid = jb[None, :] <= jq[:, None]
        forced = (jb[None, :] == 0) | (jb[None, :] == jq[:, None]) | (jb[None, :] == jq[:, None] - 1)
        imp = jnp.where(forced, SEL_FORCE, jnp.where(valid, imp, -SEL_FORCE))
        top_v, top_i = lax.top_k(imp, n_top)
        sel_ok = top_v >= 0.0
        k_sel = _gather_blocks(k_blk, top_i).reshape(B, G, Q_BLOCK, n_top * SEL_BLOCK, dh)
        v_sel = _gather_blocks(v_blk, top_i).reshape(B, G, Q_BLOCK, n_top * SEL_BLOCK, dh)
        kpos = (top_i[..., None] * SEL_BLOCK + jnp.arange(SEL_BLOCK)).reshape(B, G, Q_BLOCK, n_top * SEL_BLOCK)
        mask_s = (kpos <= tq[:, None]) & jnp.repeat(sel_ok, SEL_BLOCK, axis=-1)
        bias_s = jax.vmap(lambda t, b: t[b], in_axes=(0, 1), out_axes=1)(tbl_g, t5_bucket(tq[:, None] - kpos))
        bias_s = jnp.moveaxis(bias_s, -1, 2)
        s_s = jnp.einsum('bqghd,bgqkd->bghqk', qc, k_sel).astype(f32) * scale + bias_s
        p_s = masked_softmax(s_s, mask_s[:, :, None])
        o_s = jnp.einsum('bghqk,bgqkd->bqghd', p_s, v_sel.astype(f32))
        kwc = lax.dynamic_slice_in_dim(k_win, t0, Q_BLOCK + WINDOW, axis=1)
        vwc = lax.dynamic_slice_in_dim(v_win, t0, Q_BLOCK + WINDOW, axis=1)
        kpos_w = t0 - WINDOW + jnp.arange(Q_BLOCK + WINDOW)
        dist_w = tq[:, None] - kpos_w[None, :]
        mask_w = (dist_w >= 0) & (dist_w < WINDOW) & (kpos_w[None, :] >= 0)
        s_w = jnp.einsum('bqghd,bkgd->bghqk', qc, kwc).astype(f32) * scale + bias_2d(dist_w)
        p_w = masked_softmax(s_w, mask_w)
        o_w = jnp.einsum('bghqk,bkgd->bqghd', p_w, vwc.astype(f32))
        o = gc[..., 0:1] * o_c + gc[..., 1:2] * o_s + gc[..., 2:3] * o_w
        return o.reshape(B, Q_BLOCK, NSA_WIDTH).astype(q.dtype)

    out = lax.map(block, jnp.arange(T // Q_BLOCK))
    return jnp.moveaxis(out, 0, 1).reshape(B, T, NSA_WIDTH)


def rwkv7_time_mix(r, k, v, zw, za, zg, w0, w2, a0, a2, g2, k_k, k_a, r_k, gn_g, gn_b):
    B, T, C = r.shape
    H, N = RWKV_HEADS, RWKV_HEAD
    f32 = jnp.float32
    r, k, v = r.astype(f32), k.astype(f32), v.astype(f32)
    log_w = -jax.nn.softplus(-(w0 + jnp.tanh(zw) @ w2).astype(f32)) - 0.5
    decay = jnp.exp(-jnp.exp(log_w))
    a = jax.nn.sigmoid((a0 + za @ a2).astype(f32))
    g = (jax.nn.sigmoid(zg) @ g2).astype(f32)
    kk = (k * k_k).reshape(B, T, H, N)
    kk = kk / jnp.maximum(jnp.sqrt(jnp.sum(kk * kk, axis=-1, keepdims=True)), 1e-12)
    k = k * (1.0 + (a - 1.0) * k_a)
    heads = lambda t: jnp.moveaxis(t.reshape(B, T, H, N), 1, 0)

    def step(S, inp):
        r_t, w_t, k_t, v_t, kk_t, a_t = inp
        S = (S * w_t[:, :, None, :]
             - jnp.einsum('bhij,bhj->bhi', S, kk_t)[..., None] * (kk_t * a_t)[:, :, None, :]
             + v_t[..., None] * k_t[:, :, None, :])
        return S, jnp.einsum('bhij,bhj->bhi', S, r_t)

    S0 = jnp.zeros((B, H, N, N), f32)
    _, o = lax.scan(step, S0, (heads(r), heads(decay), heads(k), heads(v), jnp.moveaxis(kk, 1, 0), heads(a)))
    o = jnp.moveaxis(o, 0, 1)
    mu = jnp.mean(o, axis=-1, keepdims=True)
    var = jnp.mean(jnp.square(o - mu), axis=-1, keepdims=True)
    o = ((o - mu) * lax.rsqrt(var + GN_EPS)).reshape(B, T, C) * gn_g + gn_b
    bonus = jnp.sum((r * k).reshape(B, T, H, N) * r_k, axis=-1, keepdims=True) * v.reshape(B, T, H, N)
    return (o + bonus.reshape(B, T, C)) * g


def memory_cross_attention(x, mem, wq, wk, wv, wo):
    B, T, _ = x.shape
    M = mem.shape[1]
    q = (x @ wq).reshape(B, T, XATTN_HEADS, XATTN_HEAD)
    k = (mem @ wk).reshape(B, M, XATTN_HEADS, XATTN_HEAD)
    v = (mem @ wv).reshape(B, M, XATTN_HEADS, XATTN_HEAD)
    s = jnp.einsum('bqhd,bkhd->bhqk', q, k).astype(jnp.float32) * XATTN_HEAD ** -0.5
    p = jax.nn.softmax(s, axis=-1)
    o = jnp.einsum('bhqk,bkhd->bqhd', p, v.astype(jnp.float32)).astype(x.dtype)
    return o.reshape(B, T, XATTN_WIDTH) @ wo


def grouped_moe(x, router_w, router_bias, w_gate, w_up, w_down):
    B, T, D = x.shape
    n_tok = B * T
    xf = x.reshape(n_tok, D)
    s = jax.nn.sigmoid((xf @ router_w).astype(jnp.float32))
    s_sel = s + router_bias.astype(jnp.float32)
    group_score = jnp.sum(lax.top_k(s_sel.reshape(n_tok, N_EXPERT_GROUPS, EXPERTS_PER_GROUP), 2)[0], axis=-1)
    group = jnp.argmax(group_score, axis=-1)
    in_group = (jnp.arange(N_EXPERTS) // EXPERTS_PER_GROUP)[None, :] == group[:, None]
    _, e_idx = lax.top_k(jnp.where(in_group, s_sel, NEG_INF), TOP_K)
    s_top = jnp.take_along_axis(s, e_idx, axis=-1)
    gate = s_top / jnp.sum(s_top, axis=-1, keepdims=True)
    n_asg = n_tok * TOP_K
    e_flat = e_idx.reshape(-1)
    order = jnp.argsort(e_flat)
    e_sorted = e_flat[order]
    tok_sorted = order // TOP_K
    gate_sorted = gate.reshape(-1)[order]
    counts = jnp.bincount(e_flat, length=N_EXPERTS)
    padded = (counts + MOE_BLOCK - 1) // MOE_BLOCK * MOE_BLOCK
    dest = (jnp.cumsum(padded) - padded)[e_sorted] + jnp.arange(n_asg) - (jnp.cumsum(counts) - counts)[e_sorted]
    n_rows = n_asg + N_EXPERTS * MOE_BLOCK
    n_blocks = n_rows // MOE_BLOCK
    rows = jnp.zeros((n_rows, D), x.dtype).at[dest].set(xf[tok_sorted])
    block_expert = jnp.minimum(jnp.searchsorted(jnp.cumsum(padded), jnp.arange(n_blocks) * MOE_BLOCK, side='right'), N_EXPERTS - 1)

    def expert_block(args):
        xb, e = args
        return (jax.nn.silu(xb @ w_gate[e]) * (xb @ w_up[e])) @ w_down[e]

    y_rows = lax.map(expert_block, (rows.reshape(n_blocks, MOE_BLOCK, D), block_expert)).reshape(n_rows, D)
    y = jax.ops.segment_sum(y_rows[dest] * gate_sorted[:, None], tok_sorted, num_segments=n_tok)
    return y.astype(x.dtype).reshape(B, T, D)


def setup_inputs(seed: int = 0) -> dict:
    key = jax.random.key(seed)
    keys = iter(jax.random.split(key, 64))
    f32 = jnp.float32
    L, D = DEPTH, D_MODEL

    def nrm(shape, scale):
        return jax.random.normal(next(keys), shape, f32) * scale

    def gain(shape):
        return 1.0 + nrm(shape, 0.02)

    def unif(shape, lo, hi):
        return jax.random.uniform(next(keys), shape, f32, lo, hi)

    return {
        'x': nrm((BATCH, SEQ, D), 1.0),
        'mem': nrm((BATCH, MEM_LEN, D), 1.0),
        'rel_table': nrm((REL_BUCKETS, NSA_HEADS), 0.5),
        'router_w': nrm((D, N_EXPERTS), D ** -0.5),
        'router_bias': nrm((N_EXPERTS,), 0.01),
        'w_in': nrm((L, D, IN_COLS), D ** -0.5),
        'cmp_pe_k': nrm((L, CMP_LEN, HEAD_DIM), 0.1),
        'cmp_pe_v': nrm((L, CMP_LEN, HEAD_DIM), 0.1),
        'cmp_w1k': nrm((L, CMP_LEN * HEAD_DIM, CMP_HIDDEN), (CMP_LEN * HEAD_DIM) ** -0.5),
        'cmp_w2k': nrm((L, CMP_HIDDEN, HEAD_DIM), CMP_HIDDEN ** -0.5),
        'cmp_w1v': nrm((L, CMP_LEN * HEAD_DIM, CMP_HIDDEN), (CMP_LEN * HEAD_DIM) ** -0.5),
        'cmp_w2v': nrm((L, CMP_HIDDEN, HEAD_DIM), CMP_HIDDEN ** -0.5),
        'rwkv_mu': unif((L, RWKV_COLS), 0.0, 1.0),
        'rwkv_w0': unif((L, RWKV_WIDTH), -6.0, -1.0),
        'rwkv_w2': nrm((L, LORA_W, RWKV_WIDTH), 0.1),
        'rwkv_a0': nrm((L, RWKV_WIDTH), 0.1),
        'rwkv_a2': nrm((L, LORA_A, RWKV_WIDTH), LORA_A ** -0.5),
        'rwkv_g2': nrm((L, LORA_G, RWKV_WIDTH), LORA_G ** -0.5),
        'rwkv_kk': 0.85 + nrm((L, RWKV_WIDTH), 0.02),
        'rwkv_ka': gain((L, RWKV_WIDTH)),
        'rwkv_rk': nrm((L, RWKV_HEADS, RWKV_HEAD), 0.1),
        'rwkv_gn_g': gain((L, RWKV_WIDTH)),
        'rwkv_gn_b': nrm((L, RWKV_WIDTH), 0.02),
        'rwkv_v0': nrm((L - 1, RWKV_WIDTH), 0.1),
        'rwkv_v1': nrm((L - 1, RWKV_WIDTH, LORA_V), RWKV_WIDTH ** -0.5),
        'rwkv_v2': nrm((L - 1, LORA_V, RWKV_WIDTH), LORA_V ** -0.5),
        'p_nsa': nrm((L, NSA_WIDTH, D), NSA_WIDTH ** -0.5),
        'p_rwkv': nrm((L, RWKV_WIDTH, D), RWKV_WIDTH ** -0.5),
        'w_out': nrm((L, D, D), D ** -0.5 * DN_BETA),
        'ln1_g': gain((L, D)),
        'ln1_b': nrm((L, D), 0.02),
        'xq_w': nrm((L, D, XATTN_WIDTH), D ** -0.5),
        'xk_w': nrm((L, D, XATTN_WIDTH), D ** -0.5),
        'xv_w': nrm((L, D, XATTN_WIDTH), D ** -0.5 * DN_BETA),
        'xo_w': nrm((L, XATTN_WIDTH, D), XATTN_WIDTH ** -0.5 * DN_BETA),
        'ln2_g': gain((L, D)),
        'ln2_b': nrm((L, D), 0.02),
        'moe_w_gate': nrm((L, N_EXPERTS, D, EXPERT_FF), D ** -0.5),
        'moe_w_up': nrm((L, N_EXPERTS, D, EXPERT_FF), D ** -0.5),
        'moe_w_down': nrm((L, N_EXPERTS, EXPERT_FF, D), EXPERT_FF ** -0.5 * DN_BETA),
        'ln3_g': gain((L, D)),
        'ln3_b': nrm((L, D), 0.02),
    }


def reference(x, mem, rel_table, router_w, router_bias, w_in, cmp_pe_k, cmp_pe_v, cmp_w1k, cmp_w2k, cmp_w1v, cmp_w2v,
              rwkv_mu, rwkv_w0, rwkv_w2, rwkv_a0, rwkv_a2, rwkv_g2, rwkv_kk, rwkv_ka, rwkv_rk, rwkv_gn_g, rwkv_gn_b,
              rwkv_v0, rwkv_v1, rwkv_v2, p_nsa, p_rwkv, w_out, ln1_g, ln1_b, xq_w, xk_w, xv_w, xo_w, ln2_g, ln2_b,
              moe_w_gate, moe_w_up, moe_w_down, ln3_g, ln3_b):
    v_first = None
    for l in range(DEPTH):
        z_nsa, z_rwkv, z_gate = _split(x @ w_in[l], (NSA_COLS, RWKV_COLS, GATE_COLS))
        q, kc, vc, ks, vs, kw, vw, g_nsa = _split(z_nsa, (NSA_WIDTH,) + (NSA_KV,) * 6 + (3 * NSA_HEADS,))
        o_nsa = nsa_attention(q, kc, vc, ks, vs, kw, vw, g_nsa, rel_table, cmp_pe_k[l], cmp_pe_v[l],
                              cmp_w1k[l], cmp_w2k[l], cmp_w1v[l], cmp_w2v[l])
        r, k, v, zw, za, zg = _split(token_shift_mix(z_rwkv, rwkv_mu[l]), (RWKV_WIDTH,) * 3 + (LORA_W, LORA_A, LORA_G))
        if l == 0:
            v_first = v
        else:
            v = v + (v_first - v) * jax.nn.sigmoid(rwkv_v0[l - 1] + (v @ rwkv_v1[l - 1]) @ rwkv_v2[l - 1])
        o_rwkv = rwkv7_time_mix(r, k, v, zw, za, zg, rwkv_w0[l], rwkv_w2[l], rwkv_a0[l], rwkv_a2[l], rwkv_g2[l],
                                rwkv_kk[l], rwkv_ka[l], rwkv_rk[l], rwkv_gn_g[l], rwkv_gn_b[l]).astype(x.dtype)
        gate_nsa, gate_rwkv = _split(jax.nn.sigmoid(z_gate), (D_MODEL, D_MODEL))
        y = (gate_nsa * (o_nsa @ p_nsa[l]) + gate_rwkv * (o_rwkv @ p_rwkv[l])) @ w_out[l]
        x = layer_norm(DN_ALPHA * x + y, ln1_g[l], ln1_b[l])
        y = memory_cross_attention(x, mem, xq_w[l], xk_w[l], xv_w[l], xo_w[l])
        x = layer_norm(DN_ALPHA * x + y, ln2_g[l], ln2_b[l])
        y = grouped_moe(x, router_w, router_bias, moe_w_gate[l], moe_w_up[l], moe_w_down[l])
        x = layer_norm(DN_ALPHA * x + y, ln3_g[l], ln3_b[l])
    return x
```

```cpp
#include <hip/hip_runtime.h>
#include <cstdio>
#include <cstdint>

#define LAS __attribute__((address_space(3)))
#define GAS __attribute__((address_space(1)))
typedef unsigned short bf16_t;
typedef short bf16x8 __attribute__((ext_vector_type(8)));
typedef float f32x4 __attribute__((ext_vector_type(4)));
typedef float f32x2 __attribute__((ext_vector_type(2)));
typedef unsigned u32x4 __attribute__((ext_vector_type(4)));
typedef unsigned u32x2 __attribute__((ext_vector_type(2)));
typedef GAS unsigned gu32;

constexpr int NB = 4, SEQ = 8192, DM = 1024, NTOK = NB * SEQ, NLAYER = 2;
constexpr int IN_COLS = 5144;
constexpr int NEXP = 16, EFF = 512;
constexpr int MEMLEN = 256;
constexpr float LOG2E = 1.4426950408889634f;
constexpr float QSCALE = 0.125f * LOG2E;
constexpr float XQSCALE = 0.08838834764831845f * LOG2E;
constexpr float DN_ALPHA = 1.4142135623730951f;
constexpr float LN_EPS = 1e-5f, GN_EPS = 64e-5f;
constexpr float NEGV = -60000.f, MINIT = -30000.f;

constexpr size_t MiB = 1u << 20;
constexpr size_t WS_CTL = 0, CTL_ZERO_BYTES = 64 * 1024;
constexpr size_t WS_TAB = 1 * MiB;
constexpr size_t TB_BK = 0;
constexpr size_t TB_CB = 4096;
constexpr size_t TB_GATE = 16384;
constexpr size_t TB_POS = TB_GATE + (size_t)NTOK * 2 * 4;
constexpr size_t TB_LIST = TB_POS + (size_t)NTOK * 2 * 4;
static_assert(TB_LIST + (size_t)NEXP * NTOK * 4 <= 3 * MiB, "TAB");
constexpr size_t WS_W = 4 * MiB;
constexpr size_t W_IN = 0;
constexpr size_t W_GT = W_IN + (size_t)2 * 3328 * 1024 * 2;
constexpr size_t W_PN = W_GT + (size_t)2 * 2048 * 1024 * 2;
constexpr size_t W_PR = W_PN + (size_t)2 * 1024 * 512 * 2;
constexpr size_t W_OUT = W_PR + (size_t)2 * 1024 * 512 * 2;
constexpr size_t W_XQ = W_OUT + (size_t)2 * 1024 * 1024 * 2;
constexpr size_t W_XKV = W_XQ + (size_t)2 * 512 * 1024 * 2;
constexpr size_t W_XO = W_XKV + (size_t)2 * 1024 * 1024 * 2;
constexpr size_t W_C1 = W_XO + (size_t)2 * 1024 * 512 * 2;
constexpr size_t W_C2 = W_C1 + (size_t)2 * 512 * 2048 * 2;
constexpr size_t W_MEM = W_C2 + (size_t)2 * 512 * 256 * 2;
constexpr size_t W_MGU = W_MEM + (size_t)1024 * 1024 * 2;
constexpr size_t W_MD = W_MGU + (size_t)2 * 16 * 1024 * 1024 * 2;
constexpr size_t W_END = W_MD + (size_t)2 * 16 * 1024 * 512 * 2;
static_assert(W_END <= 144 * MiB, "weights region");
constexpr size_t WS_XB = 148 * MiB;
constexpr size_t WS_VF = 212 * MiB;
constexpr size_t WS_XKV = 244 * MiB;
constexpr size_t WS_Z = 248 * MiB;
constexpr size_t Z_QB = 0;
constexpr size_t Z_KV6 = 32 * MiB;
constexpr size_t Z_RKV = 81 * MiB;
constexpr size_t Z_ZL = 177 * MiB;
constexpr size_t Z_GN = 193 * MiB;
constexpr size_t Z_VL = 197 * MiB;
constexpr size_t Z_HC = 199 * MiB;
constexpr size_t Z_KCMP = 203 * MiB;
constexpr size_t Z_VCMPT = Z_KCMP + 512 * 1024;
constexpr size_t Z_ORW = 204 * MiB;
constexpr size_t Z_ZLH = 197 * MiB;
constexpr size_t Z_VAB = 236 * MiB;
constexpr size_t Z_RG = 32 * MiB;
constexpr size_t Z_G2 = 96 * MiB;
constexpr size_t Z_QX = 32 * MiB;
constexpr size_t Z_XS = 0;
constexpr size_t Z_H = 136 * MiB;
constexpr size_t MOE_ROWS_MAX = 65536 + 16 * 256;
static_assert((size_t)MOE_ROWS_MAX * 1024 * 2 <= 136 * MiB && Z_H + (size_t)MOE_ROWS_MAX * 512 * 2 <= 240 * MiB, "moe arena");
constexpr size_t WS_RKH = WS_Z + 240 * MiB;
constexpr size_t WS_END = WS_RKH + 6 * MiB;
constexpr int CW_BAR = 1024;
constexpr int CW_LPR = 6144;
constexpr int CW_NSAQ = 6656;
constexpr int CW_CMP = 7168;
constexpr int CW_CNT = 8192;
static_assert((CW_CNT + 256) * 4 <= (int)CTL_ZERO_BYTES && (CW_BAR + 3456) <= CW_CNT, "CTL");

constexpr int RING_BYTES = 131072;
constexpr int LDSCTL_OFF = RING_BYTES, MISC_OFF = LDSCTL_OFF + 320;
constexpr int LDS_BYTES = 147456;
constexpr int UT_OFF = LDSCTL_OFF + 2048;

typedef __bf16 bf16x2_t __attribute__((ext_vector_type(2)));
__device__ __forceinline__ unsigned pk2(float lo, float hi) { f32x2 v = {lo, hi}; bf16x2_t b = __builtin_convertvector(v, bf16x2_t); return __builtin_bit_cast(unsigned, b); }
__device__ __forceinline__ unsigned f2bf(float f) { return pk2(f, f) & 0xffffu; }
__device__ __forceinline__ float rsqf(float x) { return __builtin_amdgcn_rsqf(x); }
__device__ __forceinline__ float bf2f(unsigned short b) { return __builtin_bit_cast(float, (unsigned)b << 16); }
__device__ __forceinline__ float bflo(unsigned w) { return __builtin_bit_cast(float, w << 16); }
__device__ __forceinline__ float bfhi(unsigned w) { return __builtin_bit_cast(float, w & 0xffff0000u); }
__device__ __forceinline__ float ex2(float x) { return __builtin_amdgcn_exp2f(x); }
__device__ __forceinline__ float rcpf(float x) { return __builtin_amdgcn_rcpf(x); }
__device__ __forceinline__ float sigmoidf_(float x) { return rcpf(1.f + ex2(-x * LOG2E)); }
__device__ __forceinline__ float tanhf_(float x) { return 2.f * sigmoidf_(2.f * x) - 1.f; }
__device__ __forceinline__ float gelu_tanh(float x) { return x * sigmoidf_(1.5957691216057308f * (x + 0.044715f * x * x * x)); }
__device__ __forceinline__ float wave_sum(float v) {
#pragma unroll
    for (int o = 1; o < 64; o <<= 1) v += __shfl_xor(v, o);
    return v;
}
template <int CTRL> __device__ __forceinline__ float dppf(float v) {
    return __builtin_bit_cast(float, __builtin_amdgcn_update_dpp(0, __builtin_bit_cast(int, v), CTRL, 0xF, 0xF, true));
}
__device__ __forceinline__ float red4(float v) { v += dppf<0xB1>(v); v += dppf<0x4E>(v); return v; }
__device__ __forceinline__ float red8(float v) { v = red4(v); v += dppf<0x141>(v); return v; }
__device__ __forceinline__ float red16(float v) { v = red8(v); v += dppf<0x140>(v); return v; }
#define LDS_WAIT() asm volatile("s_waitcnt lgkmcnt(0)" ::: "memory")
#define VM_WAIT() asm volatile("s_waitcnt vmcnt(0)" ::: "memory")
#define RLX_AGENT __ATOMIC_RELAXED, __HIP_MEMORY_SCOPE_AGENT

namespace pg8 {
constexpr int BM = 256, BK = 64, HALF = 128, HTB = HALF * BK * 2, STAGE_BYTES = 8 * HTB, NXCD = 8, WGM = 8;
__host__ __device__ __forceinline__ int lds_byte(int r, int c) { const int st = (r >> 4) * 2 + (c >> 5), rr = r & 15, cc = c & 31, ob = rr * 64 + cc * 2; return st * 1024 + (ob ^ (((ob >> 9) & 1) << 5)); }
__host__ __device__ __forceinline__ void stage_rc(int b, int& R, int& C) { const int st = b / 1024, sb = b % 1024, swz = sb ^ (((sb >> 9) & 1) << 5); R = (st >> 1) * 16 + swz / 64; C = (st & 1) * 32 + (swz % 64) / 2; }
__host__ __device__ __forceinline__ int perm32(int rho) { const int n = rho >> 4, i = rho & 15; return 8 * (i >> 2) + 4 * n + (i & 3); }

struct Unit { int pm, pn, sel; };
struct Gemm { const bf16_t* A; const bf16_t* Bt; int lda, K; const bf16_t* A2; const bf16_t* Bt2; };

struct GridOrder {
    int nM, nN, nwg, G, c;
    __device__ void init(int M, int N, int G_, int c_) { nM = M / BM; nN = N / BM; nwg = nM * nN; G = G_; c = c_; }
    __device__ bool tile(long L, Unit& u) const {
        if (L >= nwg || c < 0) return false;
        int wgid = (int)L; { const int q = nwg / NXCD, r = nwg % NXCD, xcd = wgid % NXCD, off = wgid / NXCD; wgid = (xcd < r ? xcd * (q + 1) : r * (q + 1) + (xcd - r) * q) + off; }
        const int nig = WGM * nN, gid = wgid / nig, fm = gid * WGM, gsz = (nM - fm) < WGM ? (nM - fm) : WGM;
        u.pm = fm + ((wgid % nig) % gsz); u.pn = (wgid % nig) / gsz; u.sel = 0; return true;
    }
    __device__ bool next(int i, Unit& u) const { return tile((long)i * G + c, u); }
};
struct PairOrder {
    GridOrder g;
    __device__ bool next(int i, Unit& u) const { const bool ok = g.tile((long)(i >> 1) * g.G + g.c, u); u.sel = i & 1; return ok; }
};
struct RowOrder {
    int nM, per, G, c;
    __device__ bool next(int i, Unit& u) const { const long L = (long)i * G + c; if (L >= nM || c < 0) return false; u.pm = (int)L; u.pn = u.pm / per; u.sel = 0; return true; }
};
struct MoeOrder {
    const LAS int* pe;
    int G, c;
    __device__ bool next(int i, Unit& u) const {
        const long L = (long)i * G + c; const int total = pe[15] * 4; if (L >= total) return false;
        const int gt = (int)(L >> 2), pl = (int)(L & 3); int e = 0;
#pragma unroll
        for (int k = 0; k < 15; ++k) e += (gt >= pe[k]) ? 1 : 0;
        u.pm = gt; u.pn = e * 4 + pl; u.sel = 0; return true;
    }
};

__device__ __forceinline__ unsigned cvt_pk_bf16(float lo, float hi) { return pk2(lo, hi); }
__device__ __forceinline__ u32x4 pack8(const f32x4& a, const f32x4& b) { u32x4 w; w.x = cvt_pk_bf16(a[0], a[1]); w.y = cvt_pk_bf16(a[2], a[3]); w.z = cvt_pk_bf16(b[0], b[1]); w.w = cvt_pk_bf16(b[2], b[3]); return w; }

template <class Epi, class Sched, bool GATHER = false>
__device__ __forceinline__ void gemm_phase(LAS unsigned char* lds, const int tid, const unsigned char* wsbase, const Gemm g, const Sched& S, const Epi& E, const int* glist = nullptr, const LAS int* PEt = nullptr) {
    const int wid = __builtin_amdgcn_readfirstlane(tid >> 6), lane = tid & 63, wr = wid >> 2, wc = wid & 3, fr = lane & 15, fq = lane >> 4;
    const int K = g.K, nt = K / BK, lda = g.lda;
    const __amdgpu_buffer_rsrc_t rsrc = __builtin_amdgcn_make_buffer_rsrc((void*)wsbase, 0, 0x7ffffff0, 0x00020000);
    const unsigned oA0 = (unsigned)((const unsigned char*)g.A - wsbase), oB0 = (unsigned)((const unsigned char*)g.Bt - wsbase);
    const unsigned oA1 = g.A2 ? (unsigned)((const unsigned char*)g.A2 - wsbase) : oA0, oB1 = g.Bt2 ? (unsigned)((const unsigned char*)g.Bt2 - wsbase) : oB0;
    unsigned voffA[2], voffB[2]; int pR[2], pC[2];
#pragma unroll
    for (int i = 0; i < 2; ++i) { int R, C; stage_rc(tid * 16 + i * 8192, R, C); const int Rb = (R & ~31) + perm32(R & 31);
        voffA[i] = (unsigned)(R * lda + C) * 2u; voffB[i] = (unsigned)(Rb * K + C) * 2u; pR[i] = R; pC[i] = C; }
    const unsigned kstep = (unsigned)(BK * 2);
    const unsigned hstepA = (unsigned)HALF * (unsigned)lda * 2u, hstepB = (unsigned)HALF * (unsigned)K * 2u;
    const unsigned tstepA = 2u * hstepA, tstepB = 2u * hstepB;
    const unsigned ldsw = (unsigned)wid * 1024u;
    const int aoff = lds_byte(wr * 64 + fr, fq * 8), boff = lds_byte(wc * 32 + fr, fq * 8);
#define PG8_SA(b, h) (((b) * 2 + (h)) * HTB)
#define PG8_SB(b, h) ((4 + (b) * 2 + (h)) * HTB)
#define PG8_STAGE(bufoff, sbase, voff) do { _Pragma("unroll") for (int _i = 0; _i < 2; ++_i) \
        __builtin_amdgcn_raw_ptr_buffer_load_lds(rsrc, (LAS void*)(lds + (bufoff) + ldsw + _i * 8192), 16, (int)(voff)[_i], (int)(sbase), 0, 0); } while (0)
#define PG8_LDA(dst, b, h) do { _Pragma("unroll") for (int m = 0; m < 4; ++m) _Pragma("unroll") for (int k = 0; k < 2; ++k) dst[m][k] = *(const LAS bf16x8*)(lds + PG8_SA(b, h) + aoff + m * 2048 + k * 1024); } while (0)
#define PG8_LDB(dst, b, h) do { _Pragma("unroll") for (int n = 0; n < 2; ++n) _Pragma("unroll") for (int k = 0; k < 2; ++k) dst[n][k] = *(const LAS bf16x8*)(lds + PG8_SB(b, h) + boff + n * 2048 + k * 1024); } while (0)
#define PG8_MMA(ai, bj, At, Bt) do { __builtin_amdgcn_s_setprio(1); _Pragma("unroll") for (int m = 0; m < 4; ++m) _Pragma("unroll") for (int n = 0; n < 2; ++n) _Pragma("unroll") for (int k = 0; k < 2; ++k) \
        acc[ai][bj][m][n] = __builtin_amdgcn_mfma_f32_16x16x32_bf16(Bt[n][k], At[m][k], acc[ai][bj][m][n], 0, 0, 0); __builtin_amdgcn_s_setprio(0); } while (0)
#define PG8_WAIT_V(n) asm volatile("s_waitcnt vmcnt(" #n ")" ::: "memory")
#define PG8_WAIT_L(n) asm volatile("s_waitcnt lgkmcnt(" #n ")" ::: "memory")
#define PG8_BAR __builtin_amdgcn_s_barrier()
#define PG8_SCHED __builtin_amdgcn_sched_barrier(0)
    LAS int* UT = (LAS int*)(lds + UT_OFF);
    __syncthreads();
    if (tid == 0) { int n = 0; Unit u; while (n < 31 && S.next(n, u)) { UT[4 * n] = u.pm; UT[4 * n + 1] = u.pn; UT[4 * n + 2] = u.sel; ++n; } UT[127] = n; }
    __syncthreads();
    const int nunits = __builtin_amdgcn_readfirstlane(UT[127]);
#define UT_GET(i, u) ((i) < nunits ? ((u).pm = __builtin_amdgcn_readfirstlane(UT[4 * (i)]), (u).pn = __builtin_amdgcn_readfirstlane(UT[4 * (i) + 1]), (u).sel = __builtin_amdgcn_readfirstlane(UT[4 * (i) + 2]), true) : false)
    Unit cur, nxt; int ui = 0;
    if (!UT_GET(0, cur)) return;
    unsigned gc[2][2], gn[2][2];
#define PG8_GATH(dst, u) do { if constexpr (GATHER) { const int e_ = (u).pn >> 2, b_ = PEt[32 + e_], c_ = PEt[16 + e_]; \
        _Pragma("unroll") for (int h_ = 0; h_ < 2; ++h_) _Pragma("unroll") for (int i_ = 0; i_ < 2; ++i_) { const int s_ = (u).pm * BM + h_ * HALF + pR[i_] - b_; \
            const int tok_ = (s_ < c_) ? (glist[(size_t)e_ * NTOK + s_] >> 1) : 0; dst[h_][i_] = (unsigned)(tok_ * lda + pC[i_]) * 2u; } } } while (0)
#define PG8_STAGE_A(bufoff, half, plainoff, kt, nextu) do { if constexpr (GATHER) { unsigned v_[2]; v_[0] = (nextu) ? gn[half][0] : gc[half][0]; v_[1] = (nextu) ? gn[half][1] : gc[half][1]; \
        PG8_STAGE(bufoff, oA0 + (unsigned)(kt) * kstep, v_); } else { PG8_STAGE(bufoff, plainoff, voffA); } } while (0)
    PG8_GATH(gc, cur);
    f32x4 acc[2][2][4][2];
#pragma unroll
    for (int a = 0; a < 2; ++a)
#pragma unroll
        for (int b = 0; b < 2; ++b)
#pragma unroll
            for (int m = 0; m < 4; ++m)
#pragma unroll
                for (int n = 0; n < 2; ++n) acc[a][b][m][n] = (f32x4){0.f, 0.f, 0.f, 0.f};
    bf16x8 At[4][2], B0[2][2], B1[2][2];
    unsigned cA = (cur.sel ? oA1 : oA0) + (unsigned)cur.pm * tstepA, cB = (cur.sel ? oB1 : oB0) + (unsigned)cur.pn * tstepB;
    PG8_STAGE(PG8_SB(0, 0), cB, voffB); PG8_STAGE(PG8_SB(0, 1), cB + hstepB, voffB); PG8_STAGE_A(PG8_SA(0, 0), 0, cA, 0, false); PG8_STAGE_A(PG8_SA(0, 1), 1, cA + hstepA, 0, false);
    if (wr == 1) PG8_BAR;
    PG8_WAIT_V(2); PG8_BAR;
    PG8_STAGE(PG8_SB(1, 0), cB + kstep, voffB); PG8_STAGE_A(PG8_SA(1, 0), 0, cA + kstep, 1, false); PG8_STAGE(PG8_SB(1, 1), cB + hstepB + kstep, voffB);
    PG8_WAIT_V(6); PG8_BAR;
    for (;;) {
        const bool has_next = UT_GET(ui + 1, nxt);
        if (has_next) PG8_GATH(gn, nxt);
        const unsigned nA = has_next ? (nxt.sel ? oA1 : oA0) + (unsigned)nxt.pm * tstepA : cA, nB = has_next ? (nxt.sel ? oB1 : oB0) + (unsigned)nxt.pn * tstepB : cB;
        for (int t = 0; t < nt; t += 2) {
            const bool last = (t == nt - 2);
            const unsigned a1 = cA + (unsigned)(t + 1) * kstep;
            const unsigned a2 = last ? nA : cA + (unsigned)(t + 2) * kstep, b2 = last ? nB : cB + (unsigned)(t + 2) * kstep;
            const unsigned a3 = a2 + kstep, b3 = b2 + kstep;
            PG8_LDB(B0, 0, 0); PG8_LDB(B1, 0, 1); PG8_SCHED; PG8_LDA(At, 0, 0); PG8_STAGE_A(PG8_SA(1, 1), 1, a1 + hstepA, t + 1, false);
            PG8_WAIT_V(8); PG8_WAIT_L(0); PG8_BAR; PG8_MMA(0, 0, At, B0); PG8_MMA(0, 1, At, B1); PG8_BAR; PG8_SCHED;
            PG8_LDA(At, 0, 1); PG8_STAGE(PG8_SB(0, 0), b2, voffB); PG8_STAGE(PG8_SB(0, 1), b2 + hstepB, voffB); PG8_STAGE_A(PG8_SA(0, 0), 0, a2, (last ? 0 : t + 2), (last && has_next));
            PG8_WAIT_V(8); PG8_WAIT_L(0); PG8_BAR; PG8_MMA(1, 0, At, B0); PG8_MMA(1, 1, At, B1); PG8_BAR; PG8_SCHED;
            PG8_LDB(B0, 1, 0); PG8_LDB(B1, 1, 1); PG8_SCHED; PG8_LDA(At, 1, 0); PG8_STAGE_A(PG8_SA(0, 1), 1, a2 + hstepA, (last ? 0 : t + 2), (last && has_next));
            PG8_WAIT_V(8); PG8_WAIT_L(0); PG8_BAR; PG8_MMA(0, 0, At, B0); PG8_MMA(0, 1, At, B1); PG8_BAR; PG8_SCHED;
            PG8_LDA(At, 1, 1); PG8_STAGE(PG8_SB(1, 0), b3, voffB); PG8_STAGE(PG8_SB(1, 1), b3 + hstepB, voffB); PG8_STAGE_A(PG8_SA(1, 0), 0, a3, (last ? 1 : t + 3), (last && has_next));
            PG8_WAIT_V(8); PG8_WAIT_L(0); PG8_BAR; PG8_MMA(1, 0, At, B0); PG8_MMA(1, 1, At, B1); PG8_BAR; PG8_SCHED;
        }
        if (wr == 0) PG8_BAR;
        const bool keep = E(acc, cur, wr, wc, fr, fq);
        if (!has_next) break;
        if (!keep) {
#pragma unroll
        for (int a = 0; a < 2; ++a)
#pragma unroll
            for (int b = 0; b < 2; ++b)
#pragma unroll
                for (int m = 0; m < 4; ++m)
#pragma unroll
                    for (int n = 0; n < 2; ++n) acc[a][b][m][n] = (f32x4){0.f, 0.f, 0.f, 0.f};
        }
        cur = nxt; cA = nA; cB = nB; ++ui;
        if constexpr (GATHER) { gc[0][0] = gn[0][0]; gc[0][1] = gn[0][1]; gc[1][0] = gn[1][0]; gc[1][1] = gn[1][1]; }
        if (wr == 1) PG8_BAR;
    }
    PG8_WAIT_V(0);
    PG8_BAR;
#undef UT_GET
#undef PG8_GATH
#undef PG8_STAGE_A
#undef PG8_SA
#undef PG8_SB
#undef PG8_STAGE
#undef PG8_LDA
#undef PG8_LDB
#undef PG8_MMA
#undef PG8_WAIT_V
#undef PG8_WAIT_L
#undef PG8_BAR
#undef PG8_SCHED
}
}

namespace epi {
using pg8::Unit; using pg8::pack8; using pg8::HALF; using pg8::BM;
typedef f32x4 Acc[2][2][4][2];
#define EPI_FENCE ({ asm volatile("" ::: "memory"); 0; })
#define EPI_LOOP for (int ai = 0; ai < 2; ++ai) _Pragma("unroll") for (int m = 0; m < 4; ++m, (void)EPI_FENCE) _Pragma("unroll") for (int bj = 0; bj < 2; ++bj)
#define EPI_ROW (u.pm * BM + ai * HALF + wr * 64 + m * 16 + fr)
#define EPI_COL (bj * HALF + wc * 32 + 8 * fq)

struct InProj {
    bf16_t* qb; bf16_t* kv6; bf16_t* zl; bf16_t* rkv; float* gn; bf16_t* vab; bf16_t* zlh; bf16_t* rkh;
    __device__ __forceinline__ bool operator()(Acc& acc, const Unit& u, int wr, int wc, int fr, int fq) const {
        const int pn = u.pn; const unsigned r0 = (unsigned)(u.pm * BM + wr * 64 + fr);
        if (pn < 2 || pn >= 5) {
            if (pn < 12) {
                unsigned char* base; unsigned ldc; float sc = 1.f;
                if (pn < 2) { base = (unsigned char*)(qb + pn * 256); ldc = 512; sc = QSCALE; } else if (pn == 5) { base = (unsigned char*)zl; ldc = 256; } else { base = (unsigned char*)(rkv + (pn - 6) * 256); ldc = 1536; }
                const unsigned o0 = (r0 * ldc + (unsigned)(wc * 32 + 8 * fq)) * 2u;
#pragma unroll
                EPI_LOOP { const unsigned o = o0 + ((unsigned)(ai * HALF + m * 16) * ldc + (unsigned)(bj * HALF)) * 2u; *(u32x4*)(base + o) = pack8(acc[ai][bj][m][0] * sc, acc[ai][bj][m][1] * sc); }
                if (pn >= 6 && fr == 15) {
                    unsigned char* hb = (unsigned char*)(rkh + (pn - 6) * 256); const unsigned h0 = ((r0 >> 4) * 1536u + (unsigned)(wc * 32 + 8 * fq)) * 2u;
#pragma unroll
                    EPI_LOOP { const unsigned o = h0 + ((unsigned)(ai * 8 + m) * 1536u + (unsigned)(bj * HALF)) * 2u; *(u32x4*)(hb + o) = pack8(acc[ai][bj][m][0], acc[ai][bj][m][1]); } }
                if (pn == 5 && fr == 15) {
                    unsigned char* hb = (unsigned char*)zlh; const unsigned h0 = ((r0 >> 4) * 256u + (unsigned)(wc * 32 + 8 * fq)) * 2u;
#pragma unroll
                    EPI_LOOP { const unsigned o = h0 + ((unsigned)(ai * 8 + m) * 256u + (unsigned)(bj * HALF)) * 2u; *(u32x4*)(hb + o) = pack8(acc[ai][bj][m][0], acc[ai][bj][m][1]); } }
            } else if (wc == 1 || wc == 2) {
                unsigned char* base = (unsigned char*)vab; const unsigned o0 = (r0 * 64u + (unsigned)((wc - 1) * 32 + 8 * fq)) * 2u;
#pragma unroll
                for (int ai = 0; ai < 2; ++ai)
#pragma unroll
                    for (int m = 0; m < 4; ++m, (void)EPI_FENCE) { const unsigned o = o0 + (unsigned)(ai * HALF + m * 16) * 128u; *(u32x4*)(base + o) = pack8(acc[ai][0][m][0], acc[ai][0][m][1]); }
            } else if (wc == 0 && fq < 3) {
                unsigned char* base = (unsigned char*)gn; const unsigned o0 = (r0 * 32u + (unsigned)(8 * fq)) * 4u;
#pragma unroll
                for (int ai = 0; ai < 2; ++ai)
#pragma unroll
                    for (int m = 0; m < 4; ++m, (void)EPI_FENCE) { const unsigned o = o0 + (unsigned)(ai * HALF + m * 16) * 128u; const f32x4 a = acc[ai][0][m][0], b = acc[ai][0][m][1]; f32x4 x, y;
#pragma unroll
                        for (int e = 0; e < 4; ++e) { x[e] = sigmoidf_(a[e]); y[e] = sigmoidf_(b[e]); }
                        *(f32x4*)(base + o) = x; *(f32x4*)(base + o + 16) = y; }
            }
        } else {
            const int b = u.pm >> 5, gg = wc >> 1, d = (wc & 1) * 32 + 8 * fq; const unsigned t0 = r0 & 8191u;
#pragma unroll
            for (int bj = 0; bj < 2; ++bj) { const int which = 2 * (pn - 2) + bj; unsigned char* base = (unsigned char*)(kv6 + ((size_t)((which * 4 + b) * 2 + gg) * 8192) * 64);
                if (which == 3 || which == 5) {
                    const unsigned o0 = ((unsigned)d * 8192u + t0) * 2u;
#pragma unroll
                    for (int ai = 0; ai < 2; ++ai)
#pragma unroll
                        for (int m = 0; m < 4; ++m, (void)EPI_FENCE) { const unsigned o = o0 + (unsigned)(ai * HALF + m * 16) * 2u;
#pragma unroll
                            for (int e = 0; e < 8; ++e) *(bf16_t*)(base + o + (unsigned)e * 16384u) = (bf16_t)f2bf(acc[ai][bj][m][e >> 2][e & 3]); }
                } else {
                    const unsigned o0 = (t0 * 64u + (unsigned)d) * 2u;
#pragma unroll
                    for (int ai = 0; ai < 2; ++ai)
#pragma unroll
                        for (int m = 0; m < 4; ++m, (void)EPI_FENCE) { const unsigned o = o0 + (unsigned)(ai * HALF + m * 16) * 128u; *(u32x4*)(base + o) = pack8(acc[ai][bj][m][0], acc[ai][bj][m][1]); }
                }
            }
        }
        return false;
    }
};
struct Gates {
    bf16_t* rg; bf16_t* g2;
    __device__ __forceinline__ bool operator()(Acc& acc, const Unit& u, int wr, int wc, int fr, int fq) const {
#pragma unroll
        for (int ai = 0; ai < 2; ++ai)
#pragma unroll
            for (int m = 0; m < 4; ++m, (void)EPI_FENCE) { const int r = u.pm * BM + ai * HALF + wr * 64 + m * 16 + fr, c = u.pn * 128 + wc * 32 + 8 * fq;
                f32x4 ra, rb, ga, gb;
#pragma unroll
                for (int e = 0; e < 4; ++e) { const float s1a = sigmoidf_(acc[ai][0][m][0][e]), s2a = sigmoidf_(acc[ai][1][m][0][e]), s1b = sigmoidf_(acc[ai][0][m][1][e]), s2b = sigmoidf_(acc[ai][1][m][1][e]);
                    ga[e] = s2a; gb[e] = s2b; ra[e] = s1a * rcpf(s2a); rb[e] = s1b * rcpf(s2b); }
                *(u32x4*)(rg + (size_t)r * 1024 + c) = pack8(ra, rb); *(u32x4*)(g2 + (size_t)r * 1024 + c) = pack8(ga, gb); }
        return false;
    }
};
__device__ __forceinline__ void unpack8(const u32x4 w, f32x4& a, f32x4& b) { a[0] = bflo(w.x); a[1] = bfhi(w.x); a[2] = bflo(w.y); a[3] = bfhi(w.y); b[0] = bflo(w.z); b[1] = bfhi(w.z); b[2] = bflo(w.w); b[3] = bfhi(w.w); }
struct PairGate {
    const bf16_t* rg; bf16_t* g2;
    __device__ __forceinline__ bool operator()(Acc& acc, const Unit& u, int wr, int wc, int fr, int fq) const {
        if (u.sel == 0) {
#pragma unroll
            EPI_LOOP { const int r = EPI_ROW, c = u.pn * 256 + EPI_COL; f32x4 a, b; unpack8(*(const u32x4*)(rg + (size_t)r * 1024 + c), a, b); acc[ai][bj][m][0] *= a; acc[ai][bj][m][1] *= b; }
            return true;
        }
#pragma unroll
        EPI_LOOP { const int r = EPI_ROW, c = u.pn * 256 + EPI_COL; bf16_t* p = g2 + (size_t)r * 1024 + c; f32x4 a, b; unpack8(*(const u32x4*)p, a, b); *(u32x4*)p = pack8(acc[ai][bj][m][0] * a, acc[ai][bj][m][1] * b); }
        return false;
    }
};
struct Resid {
    const bf16_t* xin; bf16_t* out; float ysc; bool dry;
    __device__ __forceinline__ bool operator()(Acc& acc, const Unit& u, int wr, int wc, int fr, int fq) const {
#pragma unroll
        EPI_LOOP { const int r = EPI_ROW, c = u.pn * 256 + EPI_COL; const size_t o = (size_t)r * 1024 + c; f32x4 x0, x1; unpack8(*(const u32x4*)(xin + o), x0, x1);
            if (!dry) *(u32x4*)(out + o) = pack8(x0 * DN_ALPHA + acc[ai][bj][m][0] * ysc, x1 * DN_ALPHA + acc[ai][bj][m][1] * ysc); }
        return false;
    }
};
struct StoreBf16 {
    bf16_t* O; int ldc; int nct; float scale;
    __device__ __forceinline__ bool operator()(Acc& acc, const Unit& u, int wr, int wc, int fr, int fq) const {
        const int ct = u.pn % nct;
#pragma unroll
        EPI_LOOP { const int r = EPI_ROW, c = ct * 256 + EPI_COL; *(u32x4*)(O + (size_t)r * ldc + c) = pack8(acc[ai][bj][m][0] * scale, acc[ai][bj][m][1] * scale); }
        return false;
    }
};
struct MemKV {
    bf16_t* kx; bf16_t* vxt;
    __device__ __forceinline__ bool operator()(Acc& acc, const Unit& u, int wr, int wc, int fr, int fq) const {
        const unsigned r0 = (unsigned)(u.pm * BM + wr * 64 + fr);
        if (u.pn < 2) {
            unsigned char* base = (unsigned char*)(kx + u.pn * 256); const unsigned o0 = (r0 * 512u + (unsigned)(wc * 32 + 8 * fq)) * 2u;
#pragma unroll
            EPI_LOOP { const unsigned o = o0 + ((unsigned)(ai * HALF + m * 16) * 512u + (unsigned)(bj * HALF)) * 2u; *(u32x4*)(base + o) = pack8(acc[ai][bj][m][0], acc[ai][bj][m][1]); }
        } else {
            const unsigned mm0 = (unsigned)(wr * 64 + fr);
#pragma unroll
            for (int bj = 0; bj < 2; ++bj) { const int h = 2 * (u.pn - 2) + bj; unsigned char* base = (unsigned char*)(vxt + ((size_t)(u.pm * 4 + h) * 128) * 256); const unsigned o0 = ((unsigned)(wc * 32 + 8 * fq) * 256u + mm0) * 2u;
#pragma unroll
                for (int ai = 0; ai < 2; ++ai)
#pragma unroll
                    for (int m = 0; m < 4; ++m, (void)EPI_FENCE) { const unsigned o = o0 + (unsigned)(ai * HALF + m * 16) * 2u;
#pragma unroll
                        for (int e = 0; e < 8; ++e) *(bf16_t*)(base + o + (unsigned)e * 512u) = (bf16_t)f2bf(acc[ai][bj][m][e >> 2][e & 3]); } }
        }
        return false;
    }
};
struct Cmp1 {
    bf16_t* hc; const float* bias;
    __device__ __forceinline__ bool operator()(Acc& acc, const Unit& u, int wr, int wc, int fr, int fq) const {
#pragma unroll
        EPI_LOOP { const int r = EPI_ROW, c = EPI_COL; const f32x4 b0 = *(const f32x4*)(bias + u.pn * 256 + c), b1 = *(const f32x4*)(bias + u.pn * 256 + c + 4); f32x4 x = acc[ai][bj][m][0] + b0, y = acc[ai][bj][m][1] + b1;
#pragma unroll
            for (int e = 0; e < 4; ++e) { x[e] = gelu_tanh(x[e]); y[e] = gelu_tanh(y[e]); }
            *(u32x4*)(hc + (size_t)r * 256 + c) = pack8(x, y); }
        return false;
    }
};
struct Cmp2 {
    bf16_t* kc; bf16_t* vct;
    __device__ __forceinline__ bool operator()(Acc& acc, const Unit& u, int wr, int wc, int fr, int fq) const {
        if (wc < 2) {
#pragma unroll
            for (int ai = 0; ai < 2; ++ai)
#pragma unroll
                for (int m = 0; m < 4; ++m, (void)EPI_FENCE) { const int r = u.pm * BM + ai * HALF + wr * 64 + m * 16 + fr, d = wc * 32 + 8 * fq, rr = r & 4095, slab = rr >> 9, i = rr & 511;
                    if (r < 4096) *(u32x4*)(kc + ((size_t)slab * 512 + i) * 64 + d) = pack8(acc[ai][0][m][0], acc[ai][0][m][1]);
                    else {
#pragma unroll
                        for (int e = 0; e < 8; ++e) vct[((size_t)slab * 64 + d + e) * 512 + i] = (bf16_t)f2bf(acc[ai][0][m][e >> 2][e & 3]); } }
        }
        return false;
    }
};
struct MoeGU {
    bf16_t* h;
    __device__ __forceinline__ bool operator()(Acc& acc, const Unit& u, int wr, int wc, int fr, int fq) const {
        const int ct = u.pn & 3;
#pragma unroll
        for (int ai = 0; ai < 2; ++ai)
#pragma unroll
            for (int m = 0; m < 4; ++m, (void)EPI_FENCE) { const int r = u.pm * BM + ai * HALF + wr * 64 + m * 16 + fr, c = ct * 128 + wc * 32 + 8 * fq; f32x4 x, y;
#pragma unroll
                for (int e = 0; e < 4; ++e) { const float g0 = acc[ai][0][m][0][e], g1 = acc[ai][0][m][1][e]; x[e] = g0 * sigmoidf_(g0) * acc[ai][1][m][0][e]; y[e] = g1 * sigmoidf_(g1) * acc[ai][1][m][1][e]; }
                *(u32x4*)(h + (size_t)r * 512 + c) = pack8(x, y); }
        return false;
    }
};
#undef EPI_LOOP
#undef EPI_FENCE
#undef EPI_ROW
#undef EPI_COL
}

#define XB_TMO      128
#define XB_XCNT(j)  (256  + 64 * (j))
#define XB_XSUB(j)  (1280 + 64 * (j))
#define XB_XGEN(j)  (2304 + 64 * (j))
#define XB_TOP      3328
#define XB_TOPGEN   3392
#define XCD_BAR_WORDS 3456
#define XB_SPIN_CAP (1u << 18)
__device__ __forceinline__ unsigned xb_ld(unsigned* p)              { return __hip_atomic_load(p, __ATOMIC_RELAXED, __HIP_MEMORY_SCOPE_AGENT); }
__device__ __forceinline__ unsigned xb_add(unsigned* p, unsigned v) { return __hip_atomic_fetch_add(p, v, __ATOMIC_RELAXED, __HIP_MEMORY_SCOPE_AGENT); }
__device__ __forceinline__ unsigned xb_xcc_id() { return (unsigned)__builtin_amdgcn_s_getreg((3 << 11) | 20) & 0xFu; }
#define XB_SPIN(cond, bar) do { unsigned _sp = 0; while (cond) { __builtin_amdgcn_s_sleep(1); \
    if ((++_sp & 255u) == 0u) { if (xb_ld(&(bar)[XB_TMO])) break; if (_sp > XB_SPIN_CAP) { atomicAdd(&(bar)[XB_TMO], 1u); break; } } } } while (0)
struct XcdBarrier { unsigned* bar; unsigned x; volatile LAS unsigned* st; };
__device__ __forceinline__ XcdBarrier xcd_barrier_post(unsigned* bar, volatile LAS unsigned* st) {
    XcdBarrier b; b.bar = bar; b.x = xb_xcc_id(); b.st = st;
    if (threadIdx.x == 0) (void)xb_add(&bar[XB_XCNT(b.x)], 1u);
    return b;
}
__device__ __forceinline__ void xcd_barrier_complete(unsigned* bar, unsigned x, unsigned& nloc, unsigned& nx) {
    const unsigned G = gridDim.x * gridDim.y * gridDim.z;
    unsigned sum, cnt, mine, sp = 0u;
    for (;;) {
        sum = 0u; cnt = 0u; mine = 0u;
#pragma unroll
        for (unsigned j = 0; j < 16; ++j) { const unsigned c = xb_ld(&bar[XB_XCNT(j)]); sum += c; cnt += (c > 0u) ? 1u : 0u; mine = (j == x) ? c : mine; }
        if (sum == G) break;
        __builtin_amdgcn_s_sleep(1);
        if ((++sp & 255u) == 0u) { if (xb_ld(&bar[XB_TMO])) break; if (sp > XB_SPIN_CAP) { atomicAdd(&bar[XB_TMO], 1u); break; } }
    }
    nloc = mine > 0u ? mine : 1u; nx = cnt > 0u ? cnt : 1u;
}
__device__ __forceinline__ void xcd_barrier(const XcdBarrier& b) {
    asm volatile("s_waitcnt vmcnt(0)" ::: "memory");
    __syncthreads();
    if (threadIdx.x == 0) {
        unsigned* bar = b.bar; const unsigned bx = xb_xcc_id();
        __builtin_amdgcn_s_waitcnt(0);
        unsigned nloc = b.st[0], nx = b.st[1];
        if (nloc == 0u) { xcd_barrier_complete(bar, bx, nloc, nx); b.st[0] = nloc; b.st[1] = nx; }
        const unsigned old = xb_add(&bar[XB_XSUB(bx)], 1u);
        const unsigned gen = old / nloc;
        if (old + 1u == (gen + 1u) * nloc) {
            __builtin_amdgcn_fence(__ATOMIC_RELEASE, "agent");
            asm volatile("s_waitcnt vmcnt(0)" ::: "memory");
            const unsigned og = xb_add(&bar[XB_TOP], 1u);
            const unsigned tg = og / nx;
            if (og + 1u == (tg + 1u) * nx) xb_add(&bar[XB_TOPGEN], 1u);
            else XB_SPIN(xb_ld(&bar[XB_TOPGEN]) == tg, bar);
            __builtin_amdgcn_fence(__ATOMIC_ACQUIRE, "agent");
            xb_add(&bar[XB_XGEN(bx)], 1u);
            asm volatile("s_waitcnt vmcnt(0)" ::: "memory");
        } else {
            XB_SPIN(xb_ld(&bar[XB_XGEN(bx)]) == gen, bar);
            __builtin_amdgcn_fence(__ATOMIC_ACQUIRE, "agent");
            asm volatile("s_waitcnt vmcnt(0)" ::: "memory");
        }
    }
    __syncthreads();
}

struct Args { const float* in[42]; float* out; unsigned char* ws; int ph_lo, ph_hi; };
enum { I_X = 0, I_MEM, I_REL, I_RW, I_RB, I_WIN, I_PEK, I_PEV, I_W1K, I_W2K, I_W1V, I_W2V, I_MU, I_W0, I_W2, I_A0, I_A2, I_G2, I_KK, I_KA, I_RK, I_GNG, I_GNB,
       I_V0, I_V1, I_V2, I_PN, I_PR, I_WOUT, I_LN1G, I_LN1B, I_XQ, I_XK, I_XV, I_XO, I_LN2G, I_LN2B, I_MG, I_MU_, I_MD, I_LN3G, I_LN3B };
struct Frame {
    LAS unsigned char* lds;
    int tid, lane, wave, G, bid;
    unsigned char* ws;
};
constexpr int PT_OFF = LDSCTL_OFF + 1024;
__device__ __forceinline__ const float* inp(const Frame& F, int i) {
    const LAS unsigned* p = (const LAS unsigned*)(F.lds + PT_OFF) + 2 * i;
    const unsigned lo = __builtin_amdgcn_readfirstlane(p[0]), hi = __builtin_amdgcn_readfirstlane(p[1]);
    return (const float*)(((unsigned long long)hi << 32) | (unsigned long long)lo);
}

struct DstId { __device__ __forceinline__ int operator()(int d) const { return d; } };
struct DstWin1 { __device__ __forceinline__ int operator()(int d) const { return (d >= 3104 && d < 3168) ? -1 : d; } };
struct DstMoe { int up; __device__ __forceinline__ int operator()(int d) const { return (d >> 9) * 1024 + ((d >> 7) & 3) * 256 + (d & 127) + up; } };
template <class SrcF, class DstF = DstId>
__device__ __forceinline__ void cvt_item(const SrcF& src, int K, bf16_t* WT, int item, int lane, const DstF dmap = DstF()) {
    const int nk = K >> 6, nb = item / nk, kb = item - nb * nk, d0 = nb * 256 + 4 * lane, k0 = 64 * kb;
#pragma unroll 2
    for (int kc = 0; kc < 8; ++kc) {
        f32x4 v[8];
#pragma unroll
        for (int e = 0; e < 8; ++e) v[e] = src(k0 + 8 * kc + e, d0);
#pragma unroll
        for (int r = 0; r < 4; ++r) { u32x4 o; o.x = pk2(v[0][r], v[1][r]); o.y = pk2(v[2][r], v[3][r]); o.z = pk2(v[4][r], v[5][r]); o.w = pk2(v[6][r], v[7][r]);
            const int dd_ = dmap(d0 + r); if (dd_ >= 0) *(u32x4*)(WT + (size_t)dd_ * K + k0 + 8 * kc) = o; }
    }
}
struct SrcPlain { const float* W; int ldw; __device__ __forceinline__ f32x4 operator()(int k, int d) const { return *(const f32x4*)(W + (size_t)k * ldw + d); } };
struct SrcWin {
    const float* W;
    __device__ __forceinline__ f32x4 operator()(int k, int d) const {
        int c;
        if (d < 1280) c = d; else if (d < 1536) c = d - 1280 + 2840; else if (d < 3072) c = d - 1536 + 1304; else if (d < 3096) c = d - 3072 + 1280; else c = -1;
        return c < 0 ? (f32x4){0.f, 0.f, 0.f, 0.f} : *(const f32x4*)(W + (size_t)k * IN_COLS + c);
    }
};
struct SrcGates { const float* W; __device__ __forceinline__ f32x4 operator()(int k, int d) const { const int p = d >> 8, i = d & 255; const int c = (i < 128) ? (3096 + 128 * p + i) : (4120 + 128 * p + (i - 128)); return *(const f32x4*)(W + (size_t)k * IN_COLS + c); } };
struct SrcMoeG { const float* W;
    __device__ __forceinline__ f32x4 operator()(int k, int d) const { return *(const f32x4*)(W + (size_t)(d >> 9) * 1024 * 512 + (size_t)k * 512 + (d & 511)); } };
struct SrcMoeD { const float* W;
    __device__ __forceinline__ f32x4 operator()(int k, int d) const { return *(const f32x4*)(W + (size_t)(d >> 10) * 512 * 1024 + (size_t)k * 1024 + (d & 1023)); } };

__device__ __forceinline__ void cvt_item_fold(const float* win1, const float* mu_v, const float* v1, bf16_t* WT, int item, int lane) {
    const int ab = lane >> 5, n = lane & 31;
#pragma unroll 1
    for (int kk = 0; kk < 4; ++kk) { const int k = 4 * item + kk; const float* wr_ = win1 + (size_t)k * IN_COLS + 2328; float acc = 0.f;
#pragma unroll 1
        for (int c0 = 0; c0 < 512; c0 += 8) { float w8[8], m8[8], v8[8];
#pragma unroll
            for (int e = 0; e < 8; ++e) { w8[e] = wr_[c0 + e]; m8[e] = mu_v[c0 + e]; v8[e] = v1[(size_t)(c0 + e) * 32 + n]; }
#pragma unroll
            for (int e = 0; e < 8; ++e) acc += w8[e] * (ab ? m8[e] : 1.f - m8[e]) * v8[e]; }
        WT[(size_t)(3104 + 32 * ab + n) * 1024 + k] = (bf16_t)f2bf(acc); }
}
template <int SET>
__device__ __forceinline__ void convert_set(const Frame& F, int wg0, int nwg) {
    bf16_t* W = (bf16_t*)(F.ws + WS_W);
    const int gw = (F.bid - wg0) * 8 + F.wave, NGW = nwg * 8, lane = F.lane;
    constexpr int N_IN = 13 * 16, N_C1 = 1 * 32, N_XKV = 2 * 16, N_GT = 8 * 16, N_P = 4 * 8, N_OUT = 4 * 16, N_XQ = 2 * 16, N_XO = 4 * 8, N_MG = 32 * 16, N_MD = 64 * 8, N_FOLD = 256;
    enum { K_PLAIN = 0, K_WIN, K_WIN1, K_GATES, K_MOEG, K_MOEU, K_MOED, K_FOLD };
    constexpr int PER_L = 2 * N_MG + N_MD + N_GT + 2 * N_P + N_OUT + N_XQ + N_XO, L0X = N_IN + 2 * N_C1 + 2 * N_XKV, L1X = N_FOLD + L0X;
    constexpr int TOTAL = (SET == 0) ? L0X : 2 * PER_L + L1X;
    for (int it = gw; it < TOTAL; it += NGW) {
        int r = it, kind = K_PLAIN, K = 1024, ldw = 0; const float* src = nullptr; bf16_t* dst = nullptr; bool found = false;
#define JOB(cnt, KIND, SRC, LDW, KK, DST) if (!found) { if (r < (cnt)) { kind = (KIND); src = (SRC); ldw = (LDW); K = (KK); dst = (DST); found = true; } else r -= (cnt); }
#define LAYERX(l) \
        JOB(N_IN, ((l) ? K_WIN1 : K_WIN), inp(F, I_WIN) + (size_t)(l) * 1024 * IN_COLS, 0, 1024, W + W_IN / 2 + (size_t)(l) * 3328 * 1024) \
        JOB(N_C1, K_PLAIN, inp(F, I_W1K) + (size_t)(l) * 2048 * 256, 256, 2048, W + W_C1 / 2 + (size_t)(l) * 512 * 2048) \
        JOB(N_C1, K_PLAIN, inp(F, I_W1V) + (size_t)(l) * 2048 * 256, 256, 2048, W + W_C1 / 2 + (size_t)(l) * 512 * 2048 + (size_t)256 * 2048) \
        JOB(N_XKV, K_PLAIN, inp(F, I_XK) + (size_t)(l) * 1024 * 512, 512, 1024, W + W_XKV / 2 + (size_t)(l) * 1024 * 1024) \
        JOB(N_XKV, K_PLAIN, inp(F, I_XV) + (size_t)(l) * 1024 * 512, 512, 1024, W + W_XKV / 2 + (size_t)(l) * 1024 * 1024 + (size_t)512 * 1024)
#define LAYERJOBS(l) \
        JOB(N_MG, K_MOEG, inp(F, I_MG) + (size_t)(l) * 16 * 1024 * 512, 0, 1024, W + W_MGU / 2 + (size_t)(l) * 16 * 1024 * 1024) \
        JOB(N_MG, K_MOEU, inp(F, I_MU_) + (size_t)(l) * 16 * 1024 * 512, 0, 1024, W + W_MGU / 2 + (size_t)(l) * 16 * 1024 * 1024) \
        JOB(N_MD, K_MOED, inp(F, I_MD) + (size_t)(l) * 16 * 512 * 1024, 0, 512, W + W_MD / 2 + (size_t)(l) * 16 * 1024 * 512) \
        JOB(N_GT, K_GATES, inp(F, I_WIN) + (size_t)(l) * 1024 * IN_COLS, 0, 1024, W + W_GT / 2 + (size_t)(l) * 2048 * 1024) \
        JOB(N_P, K_PLAIN, inp(F, I_PN) + (size_t)(l) * 512 * 1024, 1024, 512, W + W_PN / 2 + (size_t)(l) * 1024 * 512) \
        JOB(N_P, K_PLAIN, inp(F, I_PR) + (size_t)(l) * 512 * 1024, 1024, 512, W + W_PR / 2 + (size_t)(l) * 1024 * 512) \
        JOB(N_OUT, K_PLAIN, inp(F, I_WOUT) + (size_t)(l) * 1024 * 1024, 1024, 1024, W + W_OUT / 2 + (size_t)(l) * 1024 * 1024) \
        JOB(N_XQ, K_PLAIN, inp(F, I_XQ) + (size_t)(l) * 1024 * 512, 512, 1024, W + W_XQ / 2 + (size_t)(l) * 512 * 1024) \
        JOB(N_XO, K_PLAIN, inp(F, I_XO) + (size_t)(l) * 512 * 1024, 1024, 512, W + W_XO / 2 + (size_t)(l) * 1024 * 512)
        if (SET == 0) { LAYERX(0) }
        else { JOB(N_FOLD, K_FOLD, inp(F, I_WIN) + (size_t)1024 * IN_COLS, 0, 1024, W + W_IN / 2 + (size_t)3328 * 1024) LAYERJOBS(0) LAYERJOBS(1) LAYERX(1) }
#undef JOB
#undef LAYERX
#undef LAYERJOBS
        switch (kind) {
            case K_PLAIN: cvt_item(SrcPlain{src, ldw}, K, dst, r, lane); break;
            case K_WIN:   cvt_item(SrcWin{src}, K, dst, r, lane); break;
            case K_WIN1:  cvt_item(SrcWin{src}, K, dst, r, lane, DstWin1{}); break;
            case K_GATES: cvt_item(SrcGates{src}, K, dst, r, lane); break;
            case K_MOEG:  cvt_item(SrcMoeG{src}, K, dst, r, lane, DstMoe{0}); break;
            case K_MOEU:  cvt_item(SrcMoeG{src}, K, dst, r, lane, DstMoe{128}); break;
            case K_MOED:  cvt_item(SrcMoeD{src}, K, dst, r, lane); break;
            default:      cvt_item_fold(src, inp(F, I_MU) + 1792 + 1024, inp(F, I_V1), dst, r, lane); break;
        }
    }
}
__device__ __forceinline__ void prologue(const Frame& F, const Args& a) {
    bf16_t* W = (bf16_t*)(F.ws + WS_W);
    convert_set<0>(F, 0, F.G);
    const int gt = F.bid * 512 + F.tid, NGT = F.G * 512;
    for (int i = gt; i < 2 * 2 * 256 * 256; i += NGT) { const int k = i & 255, n = (i >> 8) & 255, wh = (i >> 16) & 1, l = i >> 17;
        const float* w2 = inp(F, wh ? I_W2V : I_W2K) + (size_t)l * 256 * 64; W[W_C2 / 2 + i] = (bf16_t)((n < 64) ? f2bf(w2[k * 64 + n]) : 0u); }
    { const f32x4* x4 = (const f32x4*)inp(F, I_X); u32x2* xb = (u32x2*)(F.ws + WS_XB);
      for (int i0 = gt; i0 < NTOK * DM / 4; i0 += 8 * NGT) {
          f32x4 v[8];
#pragma unroll
          for (int u = 0; u < 8; ++u) { const int i = i0 + u * NGT; v[u] = x4[i < NTOK * DM / 4 ? i : i0]; }
#pragma unroll
          for (int u = 0; u < 8; ++u) { const int i = i0 + u * NGT; u32x2 o; o.x = pk2(v[u][0], v[u][1]); o.y = pk2(v[u][2], v[u][3]); if (i < NTOK * DM / 4) xb[i] = o; } }
      const f32x4* m4 = (const f32x4*)inp(F, I_MEM); u32x2* mb = (u32x2*)(W + W_MEM / 2);
      for (int i = gt; i < 1024 * 1024 / 4; i += NGT) { const f32x4 v = m4[i]; u32x2 o; o.x = pk2(v[0], v[1]); o.y = pk2(v[2], v[3]); mb[i] = o; } }
    if (gt < 1024) { const int n = gt; int bk;
        if (n < 16) bk = n; else { const double lr = log((double)n / 16.0) / log(64.0); int v = 16 + (int)(lr * 16.0); bk = v < 31 ? v : 31; }
        ((unsigned char*)(F.ws + WS_TAB + TB_BK))[n] = (unsigned char)bk; }
    { const int gwv = F.bid * 8 + F.wave;
      if (gwv >= 64 && gwv < 64 + 256) { const int o4 = (gwv - 64) * 4, n = o4 & 255, wh = (o4 >> 8) & 1, l = o4 >> 9;
          const float* pe = inp(F, wh ? I_PEV : I_PEK) + (size_t)l * 2048; const float* w1 = inp(F, wh ? I_W1V : I_W1K) + (size_t)l * 2048 * 256;
          const int sub = F.lane & 3, kq = F.lane >> 2;
          float sacc = 0.f;
#pragma unroll 1
          for (int i0 = 0; i0 < 128; i0 += 16) { float pv[16], wv[16];
#pragma unroll
              for (int u = 0; u < 16; ++u) { const int k = kq + 16 * (i0 + u); pv[u] = pe[k]; wv[u] = w1[(size_t)k * 256 + n + sub]; }
#pragma unroll
              for (int u = 0; u < 16; ++u) sacc += pv[u] * wv[u]; }
#pragma unroll
          for (int o = 4; o < 64; o <<= 1) sacc += __shfl_xor(sacc, o);
          if (F.lane < 4) ((float*)(F.ws + WS_TAB + TB_CB))[o4 + sub] = sacc; } }
}
struct RowV { f32x4 v[4]; };
__device__ __forceinline__ void ln_apply_store(RowV& r, const RowV& g, const RowV& b, float* orow, bf16_t* xbrow, int lane, bool wr_x = true, bool wr_xb = true) {
    float s = 0.f;
#pragma unroll
    for (int j = 0; j < 4; ++j) s += (r.v[j][0] + r.v[j][1]) + (r.v[j][2] + r.v[j][3]);
    const float mean = wave_sum(s) * (1.f / DM); float s2 = 0.f;
#pragma unroll
    for (int j = 0; j < 4; ++j) { r.v[j] = r.v[j] - mean; s2 += (r.v[j][0] * r.v[j][0] + r.v[j][1] * r.v[j][1]) + (r.v[j][2] * r.v[j][2] + r.v[j][3] * r.v[j][3]); }
    const float rstd = rsqf(wave_sum(s2) * (1.f / DM) + LN_EPS);
#pragma unroll
    for (int j = 0; j < 4; ++j) { r.v[j] = r.v[j] * rstd * g.v[j] + b.v[j];
        if (wr_x) *((f32x4*)orow + lane + 64 * j) = r.v[j];
        if (wr_xb) { u32x2 o; o.x = pk2(r.v[j][0], r.v[j][1]); o.y = pk2(r.v[j][2], r.v[j][3]); *((u32x2*)xbrow + lane + 64 * j) = o; } }
}
__device__ __forceinline__ void load_gb(const float* g, const float* b, RowV& G, RowV& B, int lane) {
#pragma unroll
    for (int j = 0; j < 4; ++j) { G.v[j] = *((const f32x4*)g + lane + 64 * j); B.v[j] = *((const f32x4*)b + lane + 64 * j); }
}
__device__ __forceinline__ void load_row_bf16(const bf16_t* yr, RowV& r, int lane) {
#pragma unroll
    for (int j = 0; j < 4; ++j) { const u32x2 w = *((const u32x2*)yr + lane + 64 * j); r.v[j][0] = bflo(w.x); r.v[j][1] = bfhi(w.x); r.v[j][2] = bflo(w.y); r.v[j][3] = bfhi(w.y); }
}
__device__ __forceinline__ void ln_phase(const Frame& F, const bf16_t* y, const float* g, const float* b, bool dry = false) {
    RowV Gv, Bv; load_gb(g, b, Gv, Bv, F.lane);
    bf16_t* xb = (bf16_t*)(F.ws + WS_XB);
#pragma unroll 2
    for (int row = F.bid * 8 + F.wave; row < NTOK; row += F.G * 8) {
        RowV r; load_row_bf16(y + (size_t)row * DM, r, F.lane);
        ln_apply_store(r, Gv, Bv, nullptr, xb + (size_t)row * DM, F.lane, false, !dry);
    }
}
__device__ __forceinline__ void ln2_route_phase(const Frame& F, const Args& a, int l, const bf16_t* y, bool dry = false) {
    LAS float* RW = (LAS float*)F.lds;
    { const float* rw = inp(F, I_RW); for (int i = F.tid; i < 1024 * 16; i += 512) { const int c = i >> 4, e = i & 15; RW[e * 1024 + c] = rw[i]; } }
    __syncthreads();
    RowV Gv, Bv; load_gb(inp(F, I_LN2G) + (size_t)l * DM, inp(F, I_LN2B) + (size_t)l * DM, Gv, Bv, F.lane);
    bf16_t* xb = (bf16_t*)(F.ws + WS_XB);
    float rb[16];
#pragma unroll
    for (int e = 0; e < 16; ++e) rb[e] = inp(F, I_RB)[e];
    unsigned* cnt = (unsigned*)(F.ws + WS_CTL) + CW_CNT + l * 64;
    int* list = (int*)(F.ws + WS_TAB + TB_LIST); float* gate = (float*)(F.ws + WS_TAB + TB_GATE); int* pos = (int*)(F.ws + WS_TAB + TB_POS);
    LAS unsigned* lcnt = (LAS unsigned*)(F.lds + 65536 + 1024);
    LAS unsigned* rec = (LAS unsigned*)(F.lds + 65536 + 2048) + F.wave * (4 * 64);
    if (F.tid < 32) lcnt[F.tid] = 0u;
    __syncthreads();
    int nrec = 0;
    for (int row = F.bid * 8 + F.wave; row < NTOK; row += F.G * 8) {
        RowV r; load_row_bf16(y + (size_t)row * DM, r, F.lane);
        ln_apply_store(r, Gv, Bv, nullptr, xb + (size_t)row * DM, F.lane, false, !dry);
        LAS float* lgt = (LAS float*)(F.lds + 65536) + F.wave * 16;
        float pa[16];
#pragma unroll
        for (int e = 0; e < 16; ++e) { float p = 0.f;
#pragma unroll
            for (int j = 0; j < 4; ++j) { const f32x4 w = *((const LAS f32x4*)(RW + e * 1024) + F.lane + 64 * j); p += (r.v[j][0] * w[0] + r.v[j][1] * w[1]) + (r.v[j][2] * w[2] + r.v[j][3] * w[3]); }
            pa[e] = p; if ((e & 3) == 3) asm volatile("" ::: "memory"); }
        { float v8[8], v4[4], v2[2];
          { const bool bt = (F.lane & 32) != 0;
#pragma unroll
            for (int i = 0; i < 8; ++i) { const float ka = bt ? pa[8 + i] : pa[i], sb = bt ? pa[i] : pa[8 + i]; v8[i] = ka + __shfl_xor(sb, 32); } }
          { const bool bt = (F.lane & 16) != 0;
#pragma unroll
            for (int i = 0; i < 4; ++i) { const float ka = bt ? v8[4 + i] : v8[i], sb = bt ? v8[i] : v8[4 + i]; v4[i] = ka + __shfl_xor(sb, 16); } }
          { const bool bt = (F.lane & 8) != 0;
#pragma unroll
            for (int i = 0; i < 2; ++i) { const float ka = bt ? v4[2 + i] : v4[i], sb = bt ? v4[i] : v4[2 + i]; v2[i] = ka + __shfl_xor(sb, 8); } }
          float v1; { const bool bt = (F.lane & 4) != 0; const float ka = bt ? v2[1] : v2[0], sb = bt ? v2[0] : v2[1]; v1 = ka + __shfl_xor(sb, 4); }
          v1 += __shfl_xor(v1, 2); v1 += __shfl_xor(v1, 1);
          const int eidx = (((F.lane >> 5) & 1) << 3) | (((F.lane >> 4) & 1) << 2) | (((F.lane >> 3) & 1) << 1) | ((F.lane >> 2) & 1);
          if ((F.lane & 3) == 0) lgt[eidx] = v1; }
        LDS_WAIT(); asm volatile("" ::: "memory");
        float s[16], ss[16];
#pragma unroll
        for (int e = 0; e < 16; ++e) { const float p = lgt[e]; s[e] = 1.f / (1.f + __expf(-p)); ss[e] = s[e] + rb[e]; }
        int bestg = 0; float bestv = -1e30f;
#pragma unroll
        for (int gi = 0; gi < 4; ++gi) { const float a0 = ss[4 * gi], a1 = ss[4 * gi + 1], a2 = ss[4 * gi + 2], a3 = ss[4 * gi + 3];
            const float hi = fmaxf(a0, a1), lo = fminf(a0, a1), hi2 = fmaxf(a2, a3), lo2 = fminf(a2, a3);
            const float gs = fmaxf(hi, hi2) + fmaxf(fminf(hi, hi2), fmaxf(lo, lo2));
            if (gs > bestv) { bestv = gs; bestg = gi; } }
        int e1 = 0; float v1 = -1e30f, s1 = 0.f;
#pragma unroll
        for (int e = 0; e < 16; ++e) { const bool ing = (e >> 2) == bestg; if (ing && ss[e] > v1) { v1 = ss[e]; e1 = e; s1 = s[e]; } }
        int e2 = 0; float v2 = -1e30f, s2v = 0.f;
#pragma unroll
        for (int e = 0; e < 16; ++e) { const bool ing = ((e >> 2) == bestg) && (e != e1); if (ing && ss[e] > v2) { v2 = ss[e]; e2 = e; s2v = s[e]; } }
        if (F.lane == 0 && !dry) { const float inv = 1.f / (s1 + s2v);
            const unsigned l1 = __hip_atomic_fetch_add(lcnt + e1, 1u, __ATOMIC_RELAXED, __HIP_MEMORY_SCOPE_WORKGROUP), l2 = __hip_atomic_fetch_add(lcnt + e2, 1u, __ATOMIC_RELAXED, __HIP_MEMORY_SCOPE_WORKGROUP);
            rec[nrec * 4 + 0] = (unsigned)row; rec[nrec * 4 + 1] = (unsigned)e1 | ((unsigned)e2 << 8); rec[nrec * 4 + 2] = l1; rec[nrec * 4 + 3] = l2;
            gate[row * 2] = s1 * inv; gate[row * 2 + 1] = s2v * inv; }
        ++nrec;
    }
    __syncthreads();
    if (F.tid < 16 && !dry) lcnt[16 + F.tid] = __hip_atomic_fetch_add(cnt + F.tid, lcnt[F.tid], RLX_AGENT);
    __syncthreads();
    if (F.lane == 0 && !dry) for (int i = 0; i < nrec; ++i) { const unsigned row = rec[i * 4], ee = rec[i * 4 + 1], e1 = ee & 255u, e2 = ee >> 8;
        const unsigned s1_ = lcnt[16 + e1] + rec[i * 4 + 2], s2_ = lcnt[16 + e2] + rec[i * 4 + 3];
        list[(size_t)e1 * NTOK + s1_] = (int)(row * 2u); list[(size_t)e2 * NTOK + s2_] = (int)(row * 2u + 1u);
        pos[row * 2u] = (int)((e1 << 24) | s1_); pos[row * 2u + 1u] = (int)((e2 << 24) | s2_); }
}
__device__ __forceinline__ void moe_tables(const Frame& F, int l, LAS int* PE) {
    if (F.tid == 0) { const unsigned* cnt = (const unsigned*)(F.ws + WS_CTL) + CW_CNT + l * 64; int acc = 0;
        for (int e = 0; e < 16; ++e) { const int c = (int)__hip_atomic_load(cnt + e, RLX_AGENT); PE[32 + e] = acc * 256; acc += (c + 255) >> 8; PE[e] = acc; PE[16 + e] = c; } }
    __syncthreads();
}
__device__ __forceinline__ void moe_gather_phase(const Frame& F, int l) {
    LAS int* PE = (LAS int*)F.lds; moe_tables(F, l, PE);
    const int total = PE[15] * 256;
    const int* list = (const int*)(F.ws + WS_TAB + TB_LIST); int* pos = (int*)(F.ws + WS_TAB + TB_POS);
    const bf16_t* xb = (const bf16_t*)(F.ws + WS_XB); bf16_t* xs = (bf16_t*)(F.ws + WS_Z + Z_XS);
    for (int R = F.bid * 8 + F.wave; R < total; R += F.G * 8) {
        const int gt = R >> 8; int e = 0;
#pragma unroll
        for (int k = 0; k < 15; ++k) e += (gt >= PE[k]) ? 1 : 0;
        const int s = R - PE[32 + e]; u32x4 v0 = (u32x4){0u, 0u, 0u, 0u}, v1 = v0;
        if (s < PE[16 + e]) { const int entry = list[(size_t)e * NTOK + s]; const u32x4* src = (const u32x4*)(xb + (size_t)(entry >> 1) * DM); v0 = src[F.lane]; v1 = src[F.lane + 64]; if (F.lane == 0) pos[entry] = R; }
        u32x4* dst = (u32x4*)(xs + (size_t)R * DM); dst[F.lane] = v0; dst[F.lane + 64] = v1;
    }
}
__device__ __forceinline__ void ln3_phase(const Frame& F, const Args& a, int l, float* x, bool wr_x, bool wr_xb) {
    RowV Gv, Bv; load_gb(inp(F, I_LN3G) + (size_t)l * DM, inp(F, I_LN3B) + (size_t)l * DM, Gv, Bv, F.lane);
    bf16_t* xb = (bf16_t*)(F.ws + WS_XB); const bf16_t* ys = (const bf16_t*)(F.ws + WS_Z + Z_XS);
    const int* pos = (const int*)(F.ws + WS_TAB + TB_POS); const float* gate = (const float*)(F.ws + WS_TAB + TB_GATE);
    LAS int* PEl = (LAS int*)F.lds; moe_tables(F, l, PEl);
    const int stride = F.G * 8;
    for (int row0 = F.bid * 8 + F.wave; row0 < NTOK; row0 += 2 * stride) {
        RowV r[2]; u32x2 xv[2][4]; u32x2 u0[2][4], u1[2][4]; float g0[2], g1[2]; int rows[2] = {row0, row0 + stride};
#pragma unroll
        for (int k = 0; k < 2; ++k) { const int row = rows[k] < NTOK ? rows[k] : row0;
            const int q0 = pos[row * 2], q1 = pos[row * 2 + 1]; const int p0 = PEl[32 + (q0 >> 24)] + (q0 & 0xffffff), p1 = PEl[32 + (q1 >> 24)] + (q1 & 0xffffff); g0[k] = gate[row * 2]; g1[k] = gate[row * 2 + 1];
            const u32x2* y0 = (const u32x2*)(ys + (size_t)p0 * DM); const u32x2* y1 = (const u32x2*)(ys + (size_t)p1 * DM); const u32x2* xr = (const u32x2*)(xb + (size_t)row * DM);
#pragma unroll
            for (int j = 0; j < 4; ++j) { xv[k][j] = xr[F.lane + 64 * j]; u0[k][j] = y0[F.lane + 64 * j]; u1[k][j] = y1[F.lane + 64 * j]; } }
#pragma unroll
        for (int k = 0; k < 2; ++k) { if (rows[k] >= NTOK) continue;
#pragma unroll
            for (int j = 0; j < 4; ++j) { f32x4 t; t[0] = bflo(u0[k][j].x) * g0[k] + bflo(u1[k][j].x) * g1[k]; t[1] = bfhi(u0[k][j].x) * g0[k] + bfhi(u1[k][j].x) * g1[k];
                t[2] = bflo(u0[k][j].y) * g0[k] + bflo(u1[k][j].y) * g1[k]; t[3] = bfhi(u0[k][j].y) * g0[k] + bfhi(u1[k][j].y) * g1[k]; f32x4 xf; xf[0] = bflo(xv[k][j].x); xf[1] = bfhi(xv[k][j].x); xf[2] = bflo(xv[k][j].y); xf[3] = bfhi(xv[k][j].y); r[k].v[j] = xf * DN_ALPHA + t; }
            ln_apply_store(r[k], Gv, Bv, x + (size_t)rows[k] * DM, xb + (size_t)rows[k] * DM, F.lane, wr_x, wr_xb); }
    }
}
namespace att {
template <int HD> struct St { float m, l; f32x4 o[HD / 16]; };
template <int HD> struct KV { bf16x8 k[2][HD / 32]; bf16x8 v[HD / 16]; };
template <int HD> __device__ __forceinline__ void init(St<HD>& st) { st.m = MINIT; st.l = 0.f;
#pragma unroll
    for (int i = 0; i < HD / 16; ++i) st.o[i] = (f32x4){0.f, 0.f, 0.f, 0.f}; }
template <int HD> __device__ __forceinline__ void load_k(KV<HD>& kv, const bf16_t* Kp, int kpitch, int fr, int fq) {
#pragma unroll
    for (int tau = 0; tau < 2; ++tau) { const int row = 8 * (fr >> 2) + 4 * tau + (fr & 3);
#pragma unroll
        for (int ks = 0; ks < HD / 32; ++ks) kv.k[tau][ks] = *(const bf16x8*)(Kp + (size_t)row * kpitch + 32 * ks + 8 * fq); }
}
template <int HD> __device__ __forceinline__ void load_v(KV<HD>& kv, const bf16_t* Vt, int vpitch, int fr, int fq) {
#pragma unroll
    for (int mt = 0; mt < HD / 16; ++mt) kv.v[mt] = *(const bf16x8*)(Vt + (size_t)(16 * mt + fr) * vpitch + 8 * fq);
}
template <int HD> __device__ __forceinline__ void qk(f32x4 (&s)[2], const bf16x8 (&qf)[HD / 32], const KV<HD>& kv, float cinit = 0.f) {
#pragma unroll
    for (int tau = 0; tau < 2; ++tau) { s[tau] = (f32x4){cinit, cinit, cinit, cinit};
#pragma unroll
        for (int ks = 0; ks < HD / 32; ++ks) s[tau] = __builtin_amdgcn_mfma_f32_16x16x32_bf16(kv.k[tau][ks], qf[ks], s[tau], 0, 0, 0); }
}
template <int HD> __device__ __forceinline__ void softmax_pv(St<HD>& st, f32x4 (&s)[2], const KV<HD>& kv) {
    float mx = fmaxf(fmaxf(fmaxf(s[0][0], s[0][1]), fmaxf(s[0][2], s[0][3])), fmaxf(fmaxf(s[1][0], s[1][1]), fmaxf(s[1][2], s[1][3])));
    if (__any(mx > st.m + 8.f)) {
        mx = fmaxf(mx, __shfl_xor(mx, 16)); mx = fmaxf(mx, __shfl_xor(mx, 32));
        const float mn = fmaxf(st.m, mx), alpha = ex2(st.m - mn); st.m = mn; st.l *= alpha;
#pragma unroll
        for (int mt = 0; mt < HD / 16; ++mt) st.o[mt] *= alpha;
    }
    float sum = 0.f; const float mref = st.m;
#pragma unroll
    for (int tau = 0; tau < 2; ++tau)
#pragma unroll
        for (int i = 0; i < 4; ++i) { s[tau][i] = ex2(s[tau][i] - mref); sum += s[tau][i]; }
    st.l += sum;
    const u32x4 pw = pg8::pack8(s[0], s[1]); const bf16x8 pB = __builtin_bit_cast(bf16x8, pw);
#pragma unroll
    for (int mt = 0; mt < HD / 16; ++mt) st.o[mt] = __builtin_amdgcn_mfma_f32_16x16x32_bf16(kv.v[mt], pB, st.o[mt], 0, 0, 0);
}
template <int HD> __device__ __forceinline__ float finish(St<HD>& st) { float lt = st.l; lt += __shfl_xor(lt, 16); lt += __shfl_xor(lt, 32); return lt > 0.f ? 1.f / lt : 0.f; }
}

constexpr int NSA_BT_BYTES = 32768, NSA_WAVE_BYTES = 2560, NSA_BUF_OFF = NSA_BT_BYTES + 8 * NSA_WAVE_BYTES, NSA_IMG = 8192, NSA_BUF_BYTES = 2 * NSA_IMG, NSA_DEPTH = 4;
static_assert(NSA_BUF_OFF + NSA_DEPTH * NSA_BUF_BYTES <= RING_BYTES, "nsa lds");
__device__ __forceinline__ void nsa_build_bias(const Frame& F, const Args& a) {
    LAS float* BT = (LAS float*)F.lds; const unsigned char* bk = (const unsigned char*)(F.ws + WS_TAB + TB_BK); const float* rel = inp(F, I_REL);
    for (int i = F.tid; i < 8 * 1024; i += 512) { const int h = i >> 10, d = i & 1023; BT[i] = rel[bk[d] * 8 + h] * LOG2E; }
    __syncthreads();
}
#define NSA_LBAR() asm volatile("s_waitcnt lgkmcnt(0)\n\ts_barrier" ::: "memory")
__device__ __forceinline__ void nsa_qk_block(f32x4 (&s)[4], const bf16x8 (&qf)[2], const LAS unsigned char* img, float cinit, int fr, int fq) {
    bf16x8 kA[4][2];
#pragma unroll
    for (int t = 0; t < 4; ++t) { const int row = 32 * (t >> 1) + 8 * (fr >> 2) + 4 * (t & 1) + (fr & 3);
#pragma unroll
        for (int ks = 0; ks < 2; ++ks) kA[t][ks] = *(const LAS bf16x8*)(img + row * 128 + (((4 * ks + fq) ^ (row & 7)) << 4)); }
#pragma unroll
    for (int t = 0; t < 4; ++t) { s[t] = (f32x4){cinit, cinit, cinit, cinit};
#pragma unroll
        for (int ks = 0; ks < 2; ++ks) s[t] = __builtin_amdgcn_mfma_f32_16x16x32_bf16(kA[t][ks], qf[ks], s[t], 0, 0, 0); }
}
__device__ __forceinline__ void nsa_softmax_pv_block(att::St<64>& st, f32x4 (&s)[4], const LAS unsigned char* img, int fr, int fq) {
    float mx = fmaxf(fmaxf(fmaxf(s[0][0], s[0][1]), fmaxf(s[0][2], s[0][3])), fmaxf(fmaxf(s[1][0], s[1][1]), fmaxf(s[1][2], s[1][3])));
    mx = fmaxf(mx, fmaxf(fmaxf(fmaxf(s[2][0], s[2][1]), fmaxf(s[2][2], s[2][3])), fmaxf(fmaxf(s[3][0], s[3][1]), fmaxf(s[3][2], s[3][3]))));
    if (__any(mx > st.m + 8.f)) {
        mx = fmaxf(mx, __shfl_xor(mx, 16)); mx = fmaxf(mx, __shfl_xor(mx, 32));
        const float mn = fmaxf(st.m, mx), alpha = ex2(st.m - mn); st.m = mn; st.l *= alpha;
#pragma unroll
        for (int mt = 0; mt < 4; ++mt) st.o[mt] *= alpha;
    }
    float sum = 0.f; const float mref = st.m;
#pragma unroll
    for (int t = 0; t < 4; ++t)
#pragma unroll
        for (int i = 0; i < 4; ++i) { s[t][i] = ex2(s[t][i] - mref); sum += s[t][i]; }
    st.l += sum;
    bf16x8 pB[2];
#pragma unroll
    for (int kp = 0; kp < 2; ++kp) { const u32x4 pw = pg8::pack8(s[2 * kp], s[2 * kp + 1]); pB[kp] = __builtin_bit_cast(bf16x8, pw); }
#pragma unroll
    for (int kp = 0; kp < 2; ++kp) { bf16x8 vA[4];
#pragma unroll
        for (int mt = 0; mt < 4; ++mt) { const int row = 16 * mt + fr; vA[mt] = *(const LAS bf16x8*)(img + NSA_IMG + row * 128 + (((4 * kp + fq) ^ (row & 7)) << 4)); }
#pragma unroll
        for (int mt = 0; mt < 4; ++mt) st.o[mt] = __builtin_amdgcn_mfma_f32_16x16x32_bf16(vA[mt], pB[kp], st.o[mt], 0, 0, 0); }
}
__device__ __forceinline__ void nsa_item(const Frame& F, int b, int g, int t0, bf16_t* obase) {
    const int lane = F.lane, fr = lane & 15, fq = lane >> 4, q = fr >> 2, hg = fr & 3, tid = F.tid;
    const int tq0 = t0 + 4 * F.wave, tq = tq0 + q, head = g * 4 + hg, tok = b * SEQ + tq, jq = t0 >> 6, slab = b * 2 + g;
    const LAS float* BTh = (const LAS float*)F.lds + head * 1024;
    LAS float* impL = (LAS float*)(F.lds + NSA_BT_BYTES + F.wave * NSA_WAVE_BYTES); LAS unsigned* selW = (LAS unsigned*)(impL + 512); LAS unsigned char* selB = (LAS unsigned char*)selW;
    LAS unsigned char* BUF = F.lds + NSA_BUF_OFF;
    bf16_t* qb = (bf16_t*)(F.ws + WS_Z + Z_QB); const bf16_t* kv6 = (const bf16_t*)(F.ws + WS_Z + Z_KV6);
    const bf16_t* KC = (const bf16_t*)(F.ws + WS_Z + Z_KCMP) + (size_t)slab * 512 * 64; const bf16_t* VCT = (const bf16_t*)(F.ws + WS_Z + Z_VCMPT) + (size_t)slab * 64 * 512;
    const size_t SLAB = (size_t)8192 * 64;
    const bf16_t* KS = kv6 + (size_t)(2 * 8 + slab) * SLAB; const bf16_t* VST = kv6 + (size_t)(3 * 8 + slab) * SLAB;
    const bf16_t* KW = kv6 + (size_t)(4 * 8 + slab) * SLAB; const bf16_t* VWT = kv6 + (size_t)(5 * 8 + slab) * SLAB;
    bf16x8 qf[2];
#pragma unroll
    for (int ks = 0; ks < 2; ++ks) qf[ks] = *(const bf16x8*)(qb + (size_t)tok * 512 + head * 64 + 32 * ks + 8 * fq);
    const float* gp = (const float*)(F.ws + WS_Z + Z_GN) + (size_t)tok * 32 + head * 3; const float gc = gp[0], gs = gp[1], gw = gp[2];
    f32x4 otot[4];
    att::St<64> st; f32x4 s[4]; const float b31 = BTh[1023];
    const int srow = 8 * F.wave + (lane >> 3), scol = (((lane & 7) ^ (lane >> 3)) & 7) * 8;
    const __amdgpu_buffer_rsrc_t rsrc = __builtin_amdgcn_make_buffer_rsrc((void*)F.ws, 0, 0x7ffffff0, 0x00020000);
    const unsigned sdstw = NSA_BUF_OFF + F.wave * 1024;
#define BIASIDX(d_) ((d_) < 0 ? 0 : ((d_) > 1023 ? 1023 : (d_)))
#define NSA_DMA(slot, KP, VP, HASV) do { \
        __builtin_amdgcn_raw_ptr_buffer_load_lds(rsrc, (LAS void*)(F.lds + sdstw + (slot) * NSA_BUF_BYTES), 16, (int)(unsigned)((const unsigned char*)(KP) - F.ws), 0, 0, 0); \
        if (HASV) __builtin_amdgcn_raw_ptr_buffer_load_lds(rsrc, (LAS void*)(F.lds + sdstw + (slot) * NSA_BUF_BYTES + NSA_IMG), 16, (int)(unsigned)((const unsigned char*)(VP) - F.ws), 0, 0, 0); } while (0)
#define NSA_PASS(FIRST, NEXT, KPTR, VPTR, HASV, ACT, STEP) do { \
        int cur_ = (FIRST); \
        if (cur_ >= 0) { \
            int pf_ = cur_;                                          \
            NSA_DMA(0, KPTR(pf_), VPTR(pf_), HASV); \
            { const int n_ = NEXT(pf_); pf_ = n_ >= 0 ? n_ : pf_; } NSA_DMA(1, KPTR(pf_), VPTR(pf_), HASV); \
            { const int n_ = NEXT(pf_); pf_ = n_ >= 0 ? n_ : pf_; } NSA_DMA(2, KPTR(pf_), VPTR(pf_), HASV); \
            int slot_ = 0; \
            for (;;) { \
                if (HASV) asm volatile("s_waitcnt vmcnt(4)" ::: "memory"); else asm volatile("s_waitcnt vmcnt(2)" ::: "memory"); \
                NSA_LBAR(); \
                { const int n_ = NEXT(pf_); pf_ = n_ >= 0 ? n_ : pf_; } NSA_DMA((slot_ + 3) & 3, KPTR(pf_), VPTR(pf_), HASV); \
                if (ACT(cur_)) { const LAS unsigned char* img_ = F.lds + NSA_BUF_OFF + slot_ * NSA_BUF_BYTES; \
                    STEP(cur_, img_); } \
                const int nxt_ = NEXT(cur_); \
                if (nxt_ < 0) break; \
                cur_ = nxt_; slot_ = (slot_ + 1) & 3; \
            } \
            asm volatile("s_waitcnt vmcnt(0)" ::: "memory"); NSA_LBAR(); \
        } } while (0)
    const int nmax = (tq0 + 3 - 31) >> 4, nsteps = (tq0 + 3 < 31) ? 0 : (nmax >> 5) + 1;
    const int nmaxW = (t0 + 31 - 31) >> 4, nblkC = (t0 + 31 < 31) ? 0 : (((nmaxW >> 5) + 1) + 1) >> 1;
#define C_NEXT(j) (((j) + 1 < nblkC) ? (j) + 1 : -1)
#define C_KPTR(j) (KC + ((size_t)(64 * (j) + srow)) * 64 + scol)
#define C_VPTR(j) (VCT + (size_t)srow * 512 + 64 * (j) + scol)
#define C_ACT(j) (2 * (j) < nsteps)
#define ELEM_LOOP _Pragma("unroll") for (int t = 0; t < 4; ++t) _Pragma("unroll") for (int i = 0; i < 4; ++i)
#define KOFF (32 * (t >> 1) + 8 * fq + 4 * (t & 1) + i)
#define C_STEP(j, img) do { \
        if (tq0 - (16 * (64 * (j) + 63) + 31) >= 1023) { nsa_qk_block(s, qf, img, b31, fr, fq); }         \
        else { nsa_qk_block(s, qf, img, 0.f, fr, fq); \
        ELEM_LOOP { const int n = 64 * (j) + KOFF, dist = tq - (16 * n + 31); const float bias = BTh[BIASIDX(dist)]; s[t][i] = dist >= 0 ? s[t][i] + bias : NEGV; } } \
        nsa_softmax_pv_block(st, s, img, fr, fq); } while (0)
    att::init(st);
    NSA_PASS((nblkC > 0 ? 0 : -1), C_NEXT, C_KPTR, C_VPTR, true, C_ACT, C_STEP);
    const float invc = att::finish(st), mc = st.m;
#pragma unroll
    for (int mt = 0; mt < 4; ++mt) otot[mt] = st.o[mt] * (invc * gc);
    const int q2 = fq, jj = fr;
    unsigned sb = 0u;
    if (jq >= 16) {
#pragma unroll
        for (int e = 0; e < 8; ++e) impL[lane * 8 + e] = 0.f;
        float carry = 0.f;
#define I_STEP(j, img) do { nsa_qk_block(s, qf, img, 0.f, fr, fq); \
        _Pragma("unroll") for (int kp = 0; kp < 2; ++kp) { float ps[8]; \
        _Pragma("unroll") for (int tau = 0; tau < 2; ++tau) _Pragma("unroll") for (int i = 0; i < 4; ++i) { const int n = 64 * (j) + 32 * kp + 8 * fq + 4 * tau + i, dist = tq - (16 * n + 31); const float bias = BTh[BIASIDX(dist)]; \
            const float p = dist >= 0 ? ex2(s[2 * kp + tau][i] + bias - mc) * invc : 0.f; ps[4 * tau + i] = red4(p); } \
        const float x1 = __shfl(ps[7], (lane + 48) & 63), x2 = __shfl(carry, (lane + 48) & 63); \
        const float prev = fq ? x1 : x2; carry = ps[7]; \
        const float imp0 = prev + ((ps[0] + ps[1]) + (ps[2] + ps[3])), imp1 = ps[3] + ((ps[4] + ps[5]) + (ps[6] + ps[7])); \
        if (hg == 0) { const int j0 = 8 * (2 * (j) + kp) + 2 * fq; impL[q * 128 + j0] = imp0; impL[q * 128 + j0 + 1] = imp1; } } } while (0)
        NSA_PASS((nblkC > 0 ? 0 : -1), C_NEXT, C_KPTR, C_VPTR, false, C_ACT, I_STEP);
        LDS_WAIT();
        float cand[8];
#pragma unroll
        for (int e = 0; e < 8; ++e) { const int j = 8 * jj + e; const float v = impL[q2 * 128 + j]; cand[e] = (j >= 1 && j <= jq - 2) ? v : -1.f; }
        for (int r = 0; r < 13; ++r) {
            float bv = cand[0]; int bi = 0;
#pragma unroll
            for (int e = 1; e < 8; ++e) { const bool gt_ = cand[e] > bv; bv = gt_ ? cand[e] : bv; bi = gt_ ? e : bi; }
            int gi = 8 * jj + bi;
#pragma unroll
            for (int sft = 1; sft < 16; sft <<= 1) { const float ov = __shfl_xor(bv, sft); const int oi = __shfl_xor(gi, sft); const bool take = ov > bv || (ov == bv && oi < gi); bv = take ? ov : bv; gi = take ? oi : gi; }
#pragma unroll
            for (int e = 0; e < 8; ++e) { const bool hit_ = (gi == 8 * jj + e); cand[e] = hit_ ? -1.f : cand[e]; sb |= hit_ ? (1u << e) : 0u; }
        }
#pragma unroll
        for (int e = 0; e < 8; ++e) { const int j = 8 * jj + e; if (j == 0 || j == jq || j == jq - 1) sb |= 1u << e; }
    } else {
#pragma unroll
        for (int e = 0; e < 8; ++e) if (8 * jj + e <= jq) sb |= 1u << e;
    }
    selB[q2 * 16 + jj] = (unsigned char)sb;
    NSA_LBAR();
    const LAS unsigned* selAll = (const LAS unsigned*)(F.lds + NSA_BT_BYTES + 2048);
    unsigned uw[4], mw[4];
#pragma unroll
    for (int w4 = 0; w4 < 4; ++w4) { unsigned u = 0u;
#pragma unroll
        for (int w = 0; w < 8; ++w) { const LAS unsigned* p = selAll + w * (NSA_WAVE_BYTES / 4); u |= p[w4] | p[4 + w4] | p[8 + w4] | p[12 + w4]; }
        uw[w4] = __builtin_amdgcn_readfirstlane(u); mw[w4] = __builtin_amdgcn_readfirstlane(selW[w4] | selW[4 + w4] | selW[8 + w4] | selW[12 + w4]); }
    const unsigned long long uLo = ((unsigned long long)uw[1] << 32) | uw[0], uHi = ((unsigned long long)uw[3] << 32) | uw[2];
    const unsigned long long mLo = ((unsigned long long)mw[1] << 32) | mw[0], mHi = ((unsigned long long)mw[3] << 32) | mw[2];
    const unsigned long long myLo = ((unsigned long long)selW[q * 4 + 1] << 32) | selW[q * 4], myHi = ((unsigned long long)selW[q * 4 + 3] << 32) | selW[q * 4 + 2];
    auto nextbit = [&](int j) -> int {
        const int jn = j + 1; if (jn >= 128) return -1;
        if (jn < 64) { const unsigned long long m = uLo >> jn; if (m) return jn + __builtin_ctzll(m); if (uHi) return 64 + __builtin_ctzll(uHi); return -1; }
        const unsigned long long m = uHi >> (jn - 64); return m ? jn + __builtin_ctzll(m) : -1; };
#define BIT128(lo, hi, j) ((((j) < 64 ? (lo) >> (j) : (hi) >> ((j) - 64)) & 1ull) != 0ull)
#define S_NEXT(j) nextbit(j)
#define S_KPTR(j) (KS + ((size_t)(64 * (j) + srow)) * 64 + scol)
#define S_VPTR(j) (VST + (size_t)srow * 8192 + 64 * (j) + scol)
#define S_ACT(j) BIT128(mLo, mHi, j)
#define S_STEP(j, img) do { const bool ok_ = BIT128(myLo, myHi, j); \
        if (tq0 - (64 * (j) + 63) >= 1023) { nsa_qk_block(s, qf, img, b31, fr, fq); ELEM_LOOP s[t][i] = ok_ ? s[t][i] : NEGV; } \
        else { nsa_qk_block(s, qf, img, 0.f, fr, fq); \
        ELEM_LOOP { const int dist = tq - (64 * (j) + KOFF); const float bias = BTh[BIASIDX(dist)]; s[t][i] = (ok_ && dist >= 0) ? s[t][i] + bias : NEGV; } } \
        nsa_softmax_pv_block(st, s, img, fr, fq); } while (0)
    att::init(st);
    NSA_PASS(0, S_NEXT, S_KPTR, S_VPTR, true, S_ACT, S_STEP);
    { const float inv = att::finish(st);
#pragma unroll
      for (int mt = 0; mt < 4; ++mt) otot[mt] += st.o[mt] * (inv * gs); }
    const int jloW = (t0 > 511 ? t0 - 511 : 0) >> 6, jloM = (tq0 > 511 ? tq0 - 511 : 0) >> 6;
#define W_NEXT(j) (((j) < jq) ? (j) + 1 : -1)
#define W_KPTR(j) (KW + ((size_t)(64 * (j) + srow)) * 64 + scol)
#define W_VPTR(j) (VWT + (size_t)srow * 8192 + 64 * (j) + scol)
#define W_ACT(j) ((j) >= jloM)
#define W_STEP(j, img) do { nsa_qk_block(s, qf, img, 0.f, fr, fq); \
        ELEM_LOOP { const int dist = tq - (64 * (j) + KOFF); const float bias = BTh[BIASIDX(dist)]; s[t][i] = (dist >= 0 && dist < 512) ? s[t][i] + bias : NEGV; } \
        nsa_softmax_pv_block(st, s, img, fr, fq); } while (0)
    att::init(st);
    NSA_PASS(jloW, W_NEXT, W_KPTR, W_VPTR, true, W_ACT, W_STEP);
    { const float inv = att::finish(st);
#pragma unroll
      for (int mt = 0; mt < 4; ++mt) otot[mt] += st.o[mt] * (inv * gw); }
#pragma unroll
    for (int mt = 0; mt < 4; ++mt) { u32x2 o; o.x = pk2(otot[mt][0], otot[mt][1]); o.y = pk2(otot[mt][2], otot[mt][3]); *(u32x2*)(obase + (size_t)tok * 512 + head * 64 + 16 * mt + 4 * fq) = o; }
#undef BIASIDX
#undef NSA_PASS
#undef C_NEXT
#undef C_KPTR
#undef C_VPTR
#undef C_ACT
#undef C_STEP
#undef I_STEP
#undef BIT128
#undef S_NEXT
#undef S_KPTR
#undef S_VPTR
#undef S_ACT
#undef S_STEP
#undef W_NEXT
#undef W_KPTR
#undef W_VPTR
#undef W_ACT
#undef W_STEP
#undef ELEM_LOOP
#undef KOFF
}
__device__ __forceinline__ void xattn_item(const Frame& F, int l, int t0, bf16_t* obase) {
    const int lane = F.lane, fr = lane & 15, fq = lane >> 4, half = F.wave >> 2, head = F.wave & 3;
    const int tok = t0 + 16 * half + fr, b = tok >> 13;
    const bf16_t* qx = (const bf16_t*)(F.ws + WS_Z + Z_QX);
    const bf16_t* K = (const bf16_t*)(F.ws + WS_XKV) + ((size_t)l * 1024 + b * 256) * 512 + head * 128;
    const bf16_t* VT = (const bf16_t*)(F.ws + WS_XKV) + (size_t)2 * 1024 * 512 + ((size_t)(l * 4 + b) * 4 + head) * 128 * 256;
    bf16x8 qf[4];
#pragma unroll
    for (int ks = 0; ks < 4; ++ks) qf[ks] = *(const bf16x8*)(qx + (size_t)tok * 512 + head * 128 + 32 * ks + 8 * fq);
    att::St<128> st; att::init(st); f32x4 s[2]; att::KV<128> A, B;
#define XLOAD(kv, kap) do { att::load_k<128>(kv, K + (size_t)32 * (kap) * 512, 512, fr, fq); att::load_v<128>(kv, VT + 32 * (kap), 256, fr, fq); } while (0)
    XLOAD(A, 0);
    for (int kap = 0; kap < 8; kap += 2) {
        XLOAD(B, kap + 1);
        att::qk<128>(s, qf, A); att::softmax_pv<128>(st, s, A);
        if (kap + 2 < 8) XLOAD(A, kap + 2);
        att::qk<128>(s, qf, B); att::softmax_pv<128>(st, s, B);
    }
#undef XLOAD
    const float inv = att::finish(st);
#pragma unroll
    for (int mt = 0; mt < 8; ++mt) { const f32x4 v = st.o[mt] * inv; u32x2 o; o.x = pk2(v[0], v[1]); o.y = pk2(v[2], v[3]); *(u32x2*)(obase + (size_t)tok * 512 + head * 128 + 16 * mt + 4 * fq) = o; }
}


__device__ __forceinline__ void lora_prep(const Frame& F, int l) {
    bf16_t* zl = (bf16_t*)(F.ws + WS_Z + Z_ZL); const bf16_t* zlh = (const bf16_t*)(F.ws + WS_Z + Z_ZLH);
    const int lane = F.lane, c0 = 4 * lane;
    const float* mu = inp(F, I_MU) + (size_t)l * 1792 + 1536 + c0; const f32x4 m4 = *(const f32x4*)mu;
    for (int grp = F.bid * 8 + F.wave; grp < NTOK / 16; grp += F.G * 8) {
        u32x2 rw[17];
#pragma unroll
        for (int i = 0; i < 16; ++i) rw[i + 1] = *(const u32x2*)(zl + (size_t)(16 * grp + i) * 256 + c0);
        rw[0] = ((grp & (SEQ / 16 - 1)) == 0) ? (u32x2){0u, 0u} : *(const u32x2*)(zlh + (size_t)(grp - 1) * 256 + c0);
#pragma unroll
        for (int i = 0; i < 16; ++i) { float y[4];
            const float c[4] = {bflo(rw[i + 1].x), bfhi(rw[i + 1].x), bflo(rw[i + 1].y), bfhi(rw[i + 1].y)}, p[4] = {bflo(rw[i].x), bfhi(rw[i].x), bflo(rw[i].y), bfhi(rw[i].y)};
#pragma unroll
            for (int e = 0; e < 4; ++e) { const float v = c[e] + m4[e] * (p[e] - c[e]); y[e] = (c0 < 64) ? tanhf_(v) : ((c0 < 128) ? v : sigmoidf_(v)); }
            u32x2 o; o.x = pk2(y[0], y[1]); o.y = pk2(y[2], y[3]); *(u32x2*)(zl + (size_t)(16 * grp + i) * 256 + c0) = o; }
        bf16_t* rkv = (bf16_t*)(F.ws + WS_Z + Z_RKV); const bf16_t* rkh = (const bf16_t*)(F.ws + WS_RKH);
#pragma unroll 1
        for (int ps = 0; ps < 6; ++ps) { const int cc = 256 * ps + c0; const f32x4 mq = *(const f32x4*)(inp(F, I_MU) + (size_t)l * 1792 + cc);
#pragma unroll
            for (int i = 0; i < 16; ++i) rw[i + 1] = *(const u32x2*)(rkv + (size_t)(16 * grp + i) * 1536 + cc);
            rw[0] = ((grp & (SEQ / 16 - 1)) == 0) ? (u32x2){0u, 0u} : *(const u32x2*)(rkh + (size_t)(grp - 1) * 1536 + cc);
#pragma unroll
            for (int i = 0; i < 16; ++i) { float y[4];
                const float c[4] = {bflo(rw[i + 1].x), bfhi(rw[i + 1].x), bflo(rw[i + 1].y), bfhi(rw[i + 1].y)}, p_[4] = {bflo(rw[i].x), bfhi(rw[i].x), bflo(rw[i].y), bfhi(rw[i].y)};
#pragma unroll
                for (int e = 0; e < 4; ++e) y[e] = c[e] + mq[e] * (p_[e] - c[e]);
                u32x2 o; o.x = pk2(y[0], y[1]); o.y = pk2(y[2], y[3]); *(u32x2*)(rkv + (size_t)(16 * grp + i) * 1536 + cc) = o; } }
    }
}


__device__ __forceinline__ void xattn_lds_item(const Frame& F, int l, int item) {
    const int lane = F.lane, fr = lane & 15, fq = lane >> 4, b = item >> 6, head = (item >> 4) & 3, chunk = item & 15;
    bf16_t* qx = (bf16_t*)(F.ws + WS_Z + Z_QX);
    const __amdgpu_buffer_rsrc_t rsrc = __builtin_amdgcn_make_buffer_rsrc((void*)F.ws, 0, 0x7ffffff0, 0x00020000);
    const unsigned oK = (unsigned)WS_XKV + (unsigned)(((size_t)l * 1024 + b * 256) * 512 + head * 128) * 2u;
    const unsigned oV = (unsigned)WS_XKV + (unsigned)((size_t)2 * 1024 * 512 + ((size_t)(l * 4 + b) * 4 + head) * 128 * 256) * 2u;
    __syncthreads();
#pragma unroll
    for (int i = 0; i < 8; ++i) { const int I = F.wave * 8 + i;
        const int r = 4 * I + (lane >> 4), c = (lane & 15) ^ (r & 15);
        __builtin_amdgcn_raw_ptr_buffer_load_lds(rsrc, (LAS void*)(F.lds + I * 1024), 16, (int)(oK + (unsigned)(r * 1024 + c * 16)), 0, 0, 0); }
#pragma unroll
    for (int i = 0; i < 8; ++i) { const int I = F.wave * 8 + i;
        const int d = 2 * I + (lane >> 5), c = (lane & 31) ^ (d & 15);
        __builtin_amdgcn_raw_ptr_buffer_load_lds(rsrc, (LAS void*)(F.lds + 65536 + I * 1024), 16, (int)(oV + (unsigned)(d * 512 + c * 16)), 0, 0, 0); }
    asm volatile("s_waitcnt vmcnt(0)" ::: "memory"); __syncthreads();
    const LAS unsigned char* KI = F.lds; const LAS unsigned char* VI = F.lds + 65536;
#pragma unroll 1
    for (int tile = 0; tile < 4; ++tile) {
        const int tok = b * SEQ + chunk * 512 + (F.wave * 4 + tile) * 16 + fr;
        bf16x8 qf[4];
#pragma unroll
        for (int ks = 0; ks < 4; ++ks) qf[ks] = *(const bf16x8*)(qx + (size_t)tok * 512 + head * 128 + 32 * ks + 8 * fq);
        att::St<128> st; att::init(st);
#pragma unroll 1
        for (int kap = 0; kap < 8; ++kap) {
            att::KV<128> kv;
#pragma unroll
            for (int tau = 0; tau < 2; ++tau) { const int row = 32 * kap + 8 * (fr >> 2) + 4 * tau + (fr & 3);
#pragma unroll
                for (int ks = 0; ks < 4; ++ks) kv.k[tau][ks] = *(const LAS bf16x8*)(KI + row * 256 + (((4 * ks + fq) ^ (row & 15)) << 4)); }
#pragma unroll
            for (int mt = 0; mt < 8; ++mt) { const int d = 16 * mt + fr; kv.v[mt] = *(const LAS bf16x8*)(VI + d * 512 + (((4 * kap + fq) ^ (d & 15)) << 4)); }
            f32x4 s2[2]; att::qk<128>(s2, qf, kv); att::softmax_pv<128>(st, s2, kv);
        }
        const float inv = att::finish(st);
#pragma unroll
        for (int mt = 0; mt < 8; ++mt) { const f32x4 v = st.o[mt] * inv; u32x2 o; o.x = pk2(v[0], v[1]); o.y = pk2(v[2], v[3]); *(u32x2*)(qx + (size_t)tok * 512 + head * 128 + 16 * mt + 4 * fq) = o; }
    }
}

namespace scan2 {
constexpr int TC = 32, ALP = 296, RP = 72, LP = 68, GP = 68;
constexpr int LARR = TC * LP * 4;
constexpr int O_AL = 0,
              O_QK = 0,
              O_LW = 18944, O_OUT = O_LW,
              O_LA = O_LW + LARR, O_LVG = O_LA + LARR, O_CUM = O_LVG + LARR,
              O_LG = O_CUM + LARR,
              O_VP = O_LG + 2 * TC * GP * 2,
              O_PR = O_VP + 2 * TC * 64 * 2,
              O_QKB = O_PR + 2 * 2 * 32 * RP * 2,
              O_VT = O_QKB + 2 * 2 * 64 * 40 * 2,
              O_FR = O_VT + 2 * 2 * 64 * 20 * 2,
              O_END = O_FR + 2 * 2 * 2048,
              O_PRM = LDSCTL_OFF + 4096,
              O_GC = O_PRM + 16 * 48 * 4,
              O_SC = O_GC + 1024;
static_assert(O_SC + 256 <= LDS_BYTES, "scan2 lds ctl");
static_assert(O_END <= RING_BYTES, "scan2 lds");
struct Raw { u32x2 zw, za, r, k, v; u32x4 zg; unsigned va, vb; u32x2 vf; };
__device__ __forceinline__ float mixf(float c, float p, float mu) { return c + mu * (p - c); }
__device__ __forceinline__ u32x2 pk4(const f32x4& v) { u32x2 o; o.x = pg8::cvt_pk_bf16(v[0], v[1]); o.y = pg8::cvt_pk_bf16(v[2], v[3]); return o; }
__device__ __forceinline__ bf16x8 mk8(const u32x2 lo, const u32x2 hi) { u32x4 w; w.x = lo.x; w.y = lo.y; w.z = hi.x; w.w = hi.y; return __builtin_bit_cast(bf16x8, w); }
#define LBAR() asm volatile("s_waitcnt lgkmcnt(0)\n\ts_barrier" ::: "memory")
#define MF16(a, b, c) __builtin_amdgcn_mfma_f32_16x16x32_bf16((a), (b), (c), 0, 0, 0)
__device__ __forceinline__ f32x4 mm16(const f32x4& yt, const f32x4& z) { const u32x2 zz = {0u, 0u}; return MF16(mk8(pk4(yt), zz), mk8(pk4(z), zz), ((f32x4){0.f, 0.f, 0.f, 0.f})); }

__device__ __forceinline__ void run(const Frame& F, const Args& a, int l, int bh) {
    const int b = bh >> 3, h = bh & 7, tid = F.tid, lane = F.lane, wave = F.wave;
    const int tl = tid >> 4, cg = tid & 15;
    const int fr = lane & 15, fq = lane >> 4, mt = wave >> 2, nt = wave & 3;
    LAS unsigned char* L = F.lds;
    LAS bf16_t* AL = (LAS bf16_t*)(L + O_AL);
    LAS float *LW = (LAS float*)(L + O_LW), *LA = (LAS float*)(L + O_LA), *LVG = (LAS float*)(L + O_LVG), *OUT = (LAS float*)(L + O_OUT),
              *SC = (LAS float*)(L + O_SC), *GC = (LAS float*)(L + O_GC), *CUM = (LAS float*)(L + O_CUM);
    LAS bf16_t *PR = (LAS bf16_t*)(L + O_PR), *QK = (LAS bf16_t*)(L + O_QK), *QKB = (LAS bf16_t*)(L + O_QKB), *VT = (LAS bf16_t*)(L + O_VT), *LG = (LAS bf16_t*)(L + O_LG), *VP = (LAS bf16_t*)(L + O_VP);
    LAS unsigned char* FR = L + O_FR;
    const bf16_t* zl = (const bf16_t*)(F.ws + WS_Z + Z_ZL); const bf16_t* rkv = (const bf16_t*)(F.ws + WS_Z + Z_RKV); const bf16_t* vab = (const bf16_t*)(F.ws + WS_Z + Z_VAB);
    bf16_t* vfb = (bf16_t*)(F.ws + WS_VF); bf16_t* orw = (bf16_t*)(F.ws + WS_Z + Z_ORW);
    LAS float* PRM = (LAS float*)(L + O_PRM);
    { const float* mu = inp(F, I_MU) + (size_t)l * 1792;
      for (int i = tid; i < 16 * 48; i += 512) { const int g_ = i / 48, k = i % 48, e = k & 3, j = 64 * h + 4 * g_ + e; float v;
          if (k < 4) v = mu[j]; else if (k < 8) v = mu[512 + j]; else if (k < 12) v = mu[1024 + j]; else if (k < 16) v = mu[1536 + 4 * g_ + e]; else if (k < 20) v = mu[1600 + 4 * g_ + e];
          else if (k < 28) v = mu[1664 + 8 * g_ + (k - 20)]; else if (k < 32) v = inp(F, I_KK)[l * 512 + j]; else if (k < 36) v = inp(F, I_KA)[l * 512 + j]; else if (k < 40) v = inp(F, I_RK)[l * 512 + j];
          else if (k < 44) v = inp(F, I_GNG)[l * 512 + j]; else v = inp(F, I_GNB)[l * 512 + j];
          PRM[i] = v; } }
    __syncthreads();
    const LAS f32x4* PR4 = (const LAS f32x4*)(PRM + cg * 48);
#define PRMV(name, idx) const f32x4 name = PR4[idx]
    bf16x8 Bw[2], Ba[2], Bg[4], Bv;
    { const int col = 64 * h + 16 * nt + fr; const float* w2 = inp(F, I_W2) + (size_t)l * 64 * 512; const float* a2 = inp(F, I_A2) + (size_t)l * 64 * 512; const float* g2 = inp(F, I_G2) + (size_t)l * 128 * 512;
#pragma unroll
      for (int ks = 0; ks < 2; ++ks)
#pragma unroll
          for (int e = 0; e < 8; ++e) { const int k = 32 * ks + 8 * fq + e; Bw[ks][e] = (short)f2bf(w2[(size_t)k * 512 + col]); Ba[ks][e] = (short)f2bf(a2[(size_t)k * 512 + col]); }
#pragma unroll
      for (int ks = 0; ks < 4; ++ks)
#pragma unroll
          for (int e = 0; e < 8; ++e) { const int k = 32 * ks + 8 * fq + e; Bg[ks][e] = (short)f2bf(g2[(size_t)k * 512 + col]); }
#pragma unroll
      for (int e = 0; e < 8; ++e) { const int k = 8 * fq + e; Bv[e] = (l > 0) ? (short)f2bf(inp(F, I_V2)[(size_t)(l - 1) * 32 * 512 + (size_t)k * 512 + col]) : (short)0; } }
    const f32x4 w0q = *(const f32x4*)(inp(F, I_W0) + l * 512 + 64 * h + 16 * nt + 4 * fq), a0q = *(const f32x4*)(inp(F, I_A0) + l * 512 + 64 * h + 16 * nt + 4 * fq);
    f32x4 v0q = {0.f, 0.f, 0.f, 0.f}; if (l > 0) v0q = *(const f32x4*)(inp(F, I_V0) + (l - 1) * 512 + 64 * h + 16 * nt + 4 * fq);
    f32x4 S[4];
#pragma unroll
    for (int m = 0; m < 4; ++m) S[m] = (f32x4){0.f, 0.f, 0.f, 0.f};
    Raw raw, rawn;
#define LOAD_RAW(raw, c_) do { const int t_ = (c_) * TC + tl; const size_t tok_ = (size_t)b * SEQ + t_; \
        raw.zw = *(const u32x2*)(zl + tok_ * 256 + 4 * cg); raw.za = *(const u32x2*)(zl + tok_ * 256 + 64 + 4 * cg); raw.zg = *(const u32x4*)(zl + tok_ * 256 + 128 + 8 * cg); \
        raw.r = *(const u32x2*)(rkv + tok_ * 1536 + 64 * h + 4 * cg); raw.k = *(const u32x2*)(rkv + tok_ * 1536 + 512 + 64 * h + 4 * cg); raw.v = *(const u32x2*)(rkv + tok_ * 1536 + 1024 + 64 * h + 4 * cg); \
        if (l > 0) { raw.va = *(const unsigned*)(vab + tok_ * 64 + 2 * cg); raw.vb = (t_ == 0) ? 0u : *(const unsigned*)(vab + (tok_ - 1) * 64 + 32 + 2 * cg); raw.vf = *(const u32x2*)(vfb + tok_ * 512 + 64 * h + 4 * cg); } else { raw.va = 0u; raw.vb = 0u; raw.vf = (u32x2){0u, 0u}; } } while (0)
    LOAD_RAW(raw, 0); LOAD_RAW(rawn, 1);
#define UNP4(dst, w) dst[0] = bflo((w).x); dst[1] = bfhi((w).x); dst[2] = bflo((w).y); dst[3] = bfhi((w).y)
#define STAGE1() do { *(LAS u32x2*)(AL + tl * ALP + 4 * cg) = raw.zw; *(LAS u32x2*)(AL + tl * ALP + 64 + 4 * cg) = raw.za; *(LAS u32x4*)(AL + tl * ALP + 128 + 8 * cg) = raw.zg; \
        *(LAS unsigned*)(AL + tl * ALP + 256 + 2 * cg) = pk2(bflo(raw.va) + bflo(raw.vb), bfhi(raw.va) + bfhi(raw.vb)); } while (0)
    STAGE1();
    LBAR();
    constexpr int NR = SEQ / TC;
    for (int c = 0; c <= NR; ++c) {
        const int p = c & 1, q = p ^ 1;
        if (c < NR) { f32x4 wl = {0.f, 0.f, 0.f, 0.f}, al = wl, gl = wl, vgl = wl;
          const LAS bf16_t* ar = AL + (16 * mt + fr) * ALP + 8 * fq;
#pragma unroll
          for (int ks = 0; ks < 2; ++ks) wl = MF16(Bw[ks], *(const LAS bf16x8*)(ar + 32 * ks), wl);
#pragma unroll
          for (int ks = 0; ks < 2; ++ks) al = MF16(Ba[ks], *(const LAS bf16x8*)(ar + 64 + 32 * ks), al);
#pragma unroll
          for (int ks = 0; ks < 4; ++ks) gl = MF16(Bg[ks], *(const LAS bf16x8*)(ar + 128 + 32 * ks), gl);
          if (l > 0) vgl = MF16(Bv, *(const LAS bf16x8*)(ar + 256), vgl);
          f32x4 lw4, cs4, la4, vg4;
#pragma unroll
          for (int i = 0; i < 4; ++i) { lw4[i] = -0.6065306597126334f * LOG2E * sigmoidf_(w0q[i] + wl[i]); la4[i] = sigmoidf_(a0q[i] + al[i]); vg4[i] = sigmoidf_(v0q[i] + vgl[i]); }
#pragma unroll
          for (int i = 0; i < 4; ++i) { float v = lw4[i]; v += dppf<0x111>(v); v += dppf<0x112>(v); v += dppf<0x114>(v); v += dppf<0x118>(v); cs4[i] = v; }
          const int o = (16 * mt + fr) * LP + 16 * nt + 4 * fq;
          *(LAS f32x4*)(LW + o) = lw4; *(LAS f32x4*)(CUM + o) = cs4; *(LAS f32x4*)(LA + o) = la4; *(LAS f32x4*)(LVG + o) = vg4;
          *(LAS u32x2*)(LG + (p * TC + 16 * mt + fr) * GP + 16 * nt + 4 * fq) = pk4(gl);
          if (fr == 15) { f32x4 g;
#pragma unroll
              for (int i = 0; i < 4; ++i) g[i] = ex2(cs4[i]);
              *(LAS f32x4*)(GC + (p * 2 + mt) * 64 + 16 * nt + 4 * fq) = g; } }
        LBAR();
        if (c < NR) { const size_t tok = (size_t)b * SEQ + c * TC + tl;
          const int ch = tl >> 4, t = tl & 15, oL = tl * LP + 4 * cg; const f32x4 av = *(const LAS f32x4*)(LA + oL), vg = *(const LAS f32x4*)(LVG + oL);
          const f32x4 cum = *(const LAS f32x4*)(CUM + oL), lwt = *(const LAS f32x4*)(LW + oL), gct = *(const LAS f32x4*)(GC + (p * 2 + ch) * 64 + 4 * cg);
          float rm[4], km[4], vm[4]; UNP4(rm, raw.r); UNP4(km, raw.k); UNP4(vm, raw.v);
          float vf4[4]; UNP4(vf4, raw.vf); PRMV(kkw, 7); PRMV(kaw, 8); PRMV(rkw, 9);
          f32x4 kk4, kp4, vp4; float n2 = 0.f;
#pragma unroll
          for (int e = 0; e < 4; ++e) { vp4[e] = (l > 0) ? vm[e] + (vf4[e] - vm[e]) * vg[e] : vm[e]; const float kx = km[e] * kkw[e]; kk4[e] = kx; n2 += kx * kx; }
          if (l == 0) { u32x2 o; o.x = pk2(vm[0], vm[1]); o.y = pk2(vm[2], vm[3]); *(u32x2*)(vfb + tok * 512 + 64 * h + 4 * cg) = o; }
          n2 = red16(n2); const float invn = rsqf(fmaxf(n2, 1e-24f));
          float bs = 0.f; f32x4 pt, rt, qh, kh, qb, kb;
#pragma unroll
          for (int e = 0; e < 4; ++e) { kk4[e] *= invn; kp4[e] = km[e] * (1.f + (av[e] - 1.f) * kaw[e]); bs += rm[e] * kp4[e] * rkw[e];
              const float gi = ex2(cum[e]), gp = ex2(cum[e] - lwt[e]), ginv = rcpf(gi), gr = gct[e] * ginv, qv = kk4[e] * av[e];
              pt[e] = -kk4[e] * gp; rt[e] = rm[e] * gi; qh[e] = qv * ginv; kh[e] = kp4[e] * ginv; qb[e] = qv * gr; kb[e] = kp4[e] * gr; }
          bs = red16(bs);
          const int pc = p * 2 + ch;
          *(LAS u32x2*)(PR + (pc * 32 + t) * RP + 4 * cg) = pk4(pt); *(LAS u32x2*)(PR + (pc * 32 + 16 + t) * RP + 4 * cg) = pk4(rt);
          *(LAS u32x2*)(QK + (ch * 32 + t) * RP + 4 * cg) = pk4(qh); *(LAS u32x2*)(QK + (ch * 32 + 16 + t) * RP + 4 * cg) = pk4(kh);
          { LAS bf16_t* qd = QKB + (pc * 64 + 4 * cg) * 40 + 8 * ((t >> 2) ^ ((cg >> 1) & 3)) + (t & 3); LAS bf16_t* vd = VT + (pc * 64 + 4 * cg) * 20 + 4 * ((t >> 2) ^ (cg >> 2)) + (t & 3);
            const unsigned v01 = pk2(vp4[0], vp4[1]), v23 = pk2(vp4[2], vp4[3]);
            vd[0] = (bf16_t)(v01 & 0xffffu); vd[20] = (bf16_t)(v01 >> 16); vd[40] = (bf16_t)(v23 & 0xffffu); vd[60] = (bf16_t)(v23 >> 16);
            { u32x2 w; w.x = v01; w.y = v23; *(LAS u32x2*)(VP + (p * TC + tl) * 64 + 4 * cg) = w; }
#pragma unroll
            for (int e = 0; e < 4; ++e) { const unsigned w = pk2(qb[e], kb[e]); qd[e * 40] = (bf16_t)(w & 0xffffu); qd[e * 40 + 4] = (bf16_t)(w >> 16); } }
          if (cg == 0) SC[p * TC + tl] = bs; }
        LBAR();
        if (c < NR) { raw = rawn; if (c + 2 < NR) LOAD_RAW(rawn, c + 2); }
        if (wave >= 4) { if (c < NR) { const int ch = wave & 1; const f32x4 z4 = {0.f, 0.f, 0.f, 0.f};
            const LAS bf16_t* pP = PR + ((p * 2 + ch) * 32 + fr) * RP + 8 * fq; const LAS bf16_t* pR = pP + 16 * RP; const LAS bf16_t* pQ = QK + (ch * 32 + fr) * RP + 8 * fq; const LAS bf16_t* pK = pQ + 16 * RP;
            LAS unsigned char* fr_ = FR + (p * 2 + ch) * 2048;
            if (wave < 6) {
                bf16x8 fP[2], fQ[2];
#pragma unroll
                for (int ks = 0; ks < 2; ++ks) { fP[ks] = *(const LAS bf16x8*)(pP + 32 * ks); fQ[ks] = *(const LAS bf16x8*)(pQ + 32 * ks); }
                f32x4 X = MF16(fP[1], fQ[1], MF16(fP[0], fQ[0], z4));
                f32x4 XT = MF16(fQ[1], fP[1], MF16(fQ[0], fP[0], z4));
                f32x4 ID;
#pragma unroll
                for (int i = 0; i < 4; ++i) { const int row = 4 * fq + i, col = fr;
                    X[i] = (col < row) ? X[i] : 0.f;
                    XT[i] = (row < col) ? XT[i] : 0.f;
                    ID[i] = (row == col) ? 1.f : 0.f; }
                const f32x4 X2 = mm16(XT, X), X2T = mm16(X, XT);
                const f32x4 X4 = mm16(X2T, X2), X4T = mm16(X2, X2T);
                const f32x4 X8 = mm16(X4T, X4);
                const f32x4 T1T = mm16(ID + X2, ID + XT);
                const f32x4 T2T = mm16(ID + X4, T1T);
                const f32x4 T3T = mm16(ID + X8, T2T);
                *(LAS u32x2*)(fr_ + lane * 8) = pk4(T3T);
            } else {
                bf16x8 fP[2], fR[2], fQ[2], fK[2];
#pragma unroll
                for (int ks = 0; ks < 2; ++ks) { fP[ks] = *(const LAS bf16x8*)(pP + 32 * ks); fR[ks] = *(const LAS bf16x8*)(pR + 32 * ks); fQ[ks] = *(const LAS bf16x8*)(pQ + 32 * ks); fK[ks] = *(const LAS bf16x8*)(pK + 32 * ks); }
                f32x4 PKT = MF16(fK[1], fP[1], MF16(fK[0], fP[0], z4));
                f32x4 RQT = MF16(fQ[1], fR[1], MF16(fQ[0], fR[0], z4));
                f32x4 RKT = MF16(fK[1], fR[1], MF16(fK[0], fR[0], z4));
#pragma unroll
                for (int i = 0; i < 4; ++i) { const int row = 4 * fq + i, col = fr;
                    PKT[i] = (row < col) ? PKT[i] : 0.f; RQT[i] = (row <= col) ? RQT[i] : 0.f; RKT[i] = (row <= col) ? RKT[i] : 0.f; }
                *(LAS u32x2*)(fr_ + 512 + lane * 8) = pk4(PKT);
                { const u32x2 lo = pk4(RQT), hi = pk4(RKT); u32x4 w; w.x = lo.x; w.y = lo.y; w.z = hi.x; w.w = hi.y; *(LAS u32x4*)(fr_ + 1024 + lane * 16) = w; }
            } }
        }
        else if (c > 0) {
#pragma unroll 1
            for (int ch = 0; ch < 2; ++ch) {
                const u32x2 zz = {0u, 0u}; const f32x4 z4 = {0.f, 0.f, 0.f, 0.f}; const int qc = q * 2 + ch;
                bf16x8 Sb[2];
#pragma unroll
                for (int kp = 0; kp < 2; ++kp) Sb[kp] = mk8(pk4(S[2 * kp]), pk4(S[2 * kp + 1]));
                const LAS bf16_t* pP = PR + (qc * 32 + fr) * RP + 4 * fq; const LAS bf16_t* pR = pP + 16 * RP;
                f32x4 x = z4, o = z4;
#pragma unroll
                for (int kp = 0; kp < 2; ++kp) { const bf16x8 aP = mk8(*(const LAS u32x2*)(pP + 32 * kp), *(const LAS u32x2*)(pP + 32 * kp + 16)), aR = mk8(*(const LAS u32x2*)(pR + 32 * kp), *(const LAS u32x2*)(pR + 32 * kp + 16));
                    x = MF16(aP, Sb[kp], x); o = MF16(aR, Sb[kp], o); }
                const LAS unsigned char* fr_ = FR + qc * 2048;
                const u32x2 vfrag = *(const LAS u32x2*)(VT + (qc * 64 + 16 * wave + fr) * 20 + 4 * (fq ^ wave));
                x = MF16(mk8(*(const LAS u32x2*)(fr_ + 512 + lane * 8), zz), mk8(vfrag, zz), x);
                const f32x4 u = MF16(mk8(*(const LAS u32x2*)(fr_ + lane * 8), zz), mk8(pk4(x), zz), z4);
                const bf16x8 UV = mk8(pk4(u), vfrag);
                o = MF16(__builtin_bit_cast(bf16x8, *(const LAS u32x4*)(fr_ + 1024 + lane * 16)), UV, o);
#pragma unroll
                for (int m = 0; m < 4; ++m) { const f32x4 gc = *(const LAS f32x4*)(GC + qc * 64 + 16 * m + 4 * fq);
                    S[m] = MF16(*(const LAS bf16x8*)(QKB + (qc * 64 + 16 * m + fr) * 40 + 8 * (fq ^ ((2 * m + (fr >> 3)) & 3))), UV, S[m] * gc); }
#pragma unroll
                for (int i = 0; i < 4; ++i) OUT[(16 * ch + 4 * fq + i) * 64 + 16 * wave + fr] = o[i];
            }
        }
        LBAR();
        if (c > 0) { const size_t tok = (size_t)b * SEQ + (c - 1) * TC + tl;
          const int o4 = tl * 64 + 4 * cg; const f32x4 ov = *(const LAS f32x4*)(OUT + o4); const u32x2 vw = *(const LAS u32x2*)(VP + (q * TC + tl) * 64 + 4 * cg), gw = *(const LAS u32x2*)(LG + (q * TC + tl) * GP + 4 * cg); const float bs = SC[q * TC + tl];
          float vp4[4], g4[4]; UNP4(vp4, vw); UNP4(g4, gw);
          const float mean = red16((ov[0] + ov[1]) + (ov[2] + ov[3])) * (1.f / 64.f); f32x4 d = ov - mean;
          const float var = red16((d[0] * d[0] + d[1] * d[1]) + (d[2] * d[2] + d[3] * d[3])) * (1.f / 64.f); const float rs = rsqf(var + GN_EPS);
          PRMV(gng, 10); PRMV(gnb, 11);
          float y[4];
#pragma unroll
          for (int e = 0; e < 4; ++e) y[e] = ((d[e] * rs) * gng[e] + gnb[e] + bs * vp4[e]) * g4[e];
          u32x2 o; o.x = pk2(y[0], y[1]); o.y = pk2(y[2], y[3]); *(u32x2*)(orw + tok * 512 + 64 * h + 4 * cg) = o; }
        if (c < NR) STAGE1();
        LBAR();
    }
#undef STAGE1
#undef UNP4
    __syncthreads();
#undef PRMV
#undef LOAD_RAW
}
#undef MF16
}

#ifndef MK_SPLIT
#define MK_SPLIT 0
#endif
constexpr int PH_PER_LAYER = 16, N_PHASES = 1 + NLAYER * PH_PER_LAYER;

#ifndef PHMASK
#define PHMASK 0xFFFFFFFFu
#endif
#define PHON(k) ((PHMASK >> (k)) & 1u)
#if MK_SPLIT
#define IN(k) (lo <= (k) && (k) < hi)
#else
#define IN(k) ((k) < N_PHASES)
#endif
#define PH_BEGIN() do { asm volatile("" : "+v"(F.tid)); asm volatile("" : "+s"(F.ws)); asm volatile("" : "+s"(X)); F.lane = F.tid & 63; F.wave = __builtin_amdgcn_readfirstlane(F.tid >> 6); } while (0)
#define SEAM(k) do { if (IN((k) + 1)) { XcdBarrier b_ = bar; asm volatile("" : "+s"(b_.bar)); xcd_barrier(b_); } } while (0)
template <int l>
__device__ __forceinline__ bool layer_body(Frame& F, const Args& args, float*& X, const XcdBarrier& bar, LAS int* PE, const int G, const int bid) {
        const int pb = 1 + l * PH_PER_LAYER;
        if (PHON(1) && IN(pb + 0)) { PH_BEGIN();
            { pg8::Gemm g{(bf16_t*)(F.ws + WS_XB), (bf16_t*)(F.ws + WS_W) + W_IN / 2 + (size_t)l * 3328 * 1024, 1024, 1024, nullptr, nullptr}; pg8::GridOrder S; S.init(NTOK, 3328, G, bid);
              epi::InProj E{(bf16_t*)(F.ws + WS_Z + Z_QB), (bf16_t*)(F.ws + WS_Z + Z_KV6), (bf16_t*)(F.ws + WS_Z + Z_ZL), (bf16_t*)(F.ws + WS_Z + Z_RKV), (float*)(F.ws + WS_Z + Z_GN), (bf16_t*)(F.ws + WS_Z + Z_VAB), (bf16_t*)(F.ws + WS_Z + Z_ZLH), (bf16_t*)(F.ws + WS_RKH)};
              pg8::gemm_phase(F.lds, F.tid, F.ws, g, S, E); }
            { pg8::Gemm g{(bf16_t*)(F.ws + WS_W) + W_MEM / 2, (bf16_t*)(F.ws + WS_W) + W_XKV / 2 + (size_t)l * 1024 * 1024, 1024, 1024, nullptr, nullptr}; pg8::GridOrder S; S.init(1024, 1024, G, bid - G / 2);
              epi::MemKV E{(bf16_t*)(F.ws + WS_XKV) + (size_t)l * 1024 * 512, (bf16_t*)(F.ws + WS_XKV) + (size_t)2 * 1024 * 512 + (size_t)l * 16 * 128 * 256};
              pg8::gemm_phase(F.lds, F.tid, F.ws, g, S, E); }
            SEAM(pb + 0);
        }
        if (PHON(4) && IN(pb + 3)) { PH_BEGIN();
            unsigned* lcnt = (unsigned*)(F.ws + WS_CTL) + CW_LPR + 64 * l;
            {
                lora_prep(F, l); VM_WAIT(); __syncthreads();
                if (F.tid == 0) { __builtin_amdgcn_fence(__ATOMIC_RELEASE, "agent"); VM_WAIT(); __hip_atomic_fetch_add(lcnt, 1u, RLX_AGENT); }
            }
#ifndef NO_SCAN
            if (bid < 32) {
                { if (F.tid == 0) { unsigned sp = 0u; while (__hip_atomic_load(lcnt, RLX_AGENT) < (unsigned)G) { __builtin_amdgcn_s_sleep(2); if (++sp > (1u << 22)) break; } __builtin_amdgcn_fence(__ATOMIC_ACQUIRE, "agent"); VM_WAIT(); } __syncthreads(); }
                    scan2::run(F, args, l, bid); }
#else
            if (bid < 32) {}
#endif
#ifndef NO_NSA
            {
                unsigned* ccnt = (unsigned*)(F.ws + WS_CTL) + CW_CMP + 64 * l;
                {
                if (bid < 32) {}
                else if (bid < 64) {
                    { pg8::Gemm g{(const bf16_t*)(F.ws + WS_Z + Z_KV6), (bf16_t*)(F.ws + WS_W) + W_C1 / 2 + (size_t)l * 512 * 2048, 1024, 2048, nullptr, nullptr}; pg8::RowOrder S{32, 16, 32, bid - 32};
                      epi::Cmp1 E{(bf16_t*)(F.ws + WS_Z + Z_HC), (const float*)(F.ws + WS_TAB + TB_CB) + l * 512};
                      pg8::gemm_phase(F.lds, F.tid, F.ws, g, S, E); }
                    VM_WAIT(); __syncthreads(); __builtin_amdgcn_fence(__ATOMIC_ACQUIRE, "agent"); VM_WAIT(); __syncthreads();
                    { pg8::Gemm g{(const bf16_t*)(F.ws + WS_Z + Z_HC), (bf16_t*)(F.ws + WS_W) + W_C2 / 2 + (size_t)l * 512 * 256, 256, 256, nullptr, nullptr}; pg8::RowOrder S{32, 16, 32, bid - 32};
                      epi::Cmp2 E{(bf16_t*)(F.ws + WS_Z + Z_KCMP), (bf16_t*)(F.ws + WS_Z + Z_VCMPT)};
                      pg8::gemm_phase(F.lds, F.tid, F.ws, g, S, E); }
                    VM_WAIT(); __syncthreads();
                    if (F.tid == 0) { __builtin_amdgcn_fence(__ATOMIC_RELEASE, "agent"); VM_WAIT(); __hip_atomic_fetch_add(ccnt, 1u, RLX_AGENT); }
                } else if (l == 0) convert_set<1>(F, 64, G - 64);
                if (F.tid == 0) { unsigned sp = 0u; while (__hip_atomic_load(ccnt, RLX_AGENT) < 32u) { __builtin_amdgcn_s_sleep(2); if (++sp > (1u << 22)) break; } __builtin_amdgcn_fence(__ATOMIC_ACQUIRE, "agent"); VM_WAIT(); }
                __syncthreads();
                }
                    nsa_build_bias(F, args);
                {
                    unsigned* qh = (unsigned*)(F.ws + WS_CTL) + CW_NSAQ + 64 * l; volatile LAS unsigned* qslot = (volatile LAS unsigned*)(F.lds + LDSCTL_OFF + 256);
                    for (;;) {
                        if (F.tid == 0) qslot[0] = __hip_atomic_fetch_add(qh, 1u, RLX_AGENT);
                        __syncthreads();
                        const int id = (int)__builtin_amdgcn_readfirstlane(qslot[0]);
                        __syncthreads();
                        if (id >= 2048) break;
                        const int tt = 255 - (id >> 3), slab = id & 7; nsa_item(F, slab >> 1, slab & 1, tt * 32, (bf16_t*)(F.ws + WS_Z + Z_QB));
                    } }
                __syncthreads(); }
#endif
            SEAM(pb + 3);
        }
        if (PHON(5) && IN(pb + 4)) { PH_BEGIN();
            pg8::Gemm g{(bf16_t*)(F.ws + WS_XB), (bf16_t*)(F.ws + WS_W) + W_GT / 2 + (size_t)l * 2048 * 1024, 1024, 1024, nullptr, nullptr}; pg8::GridOrder S; S.init(NTOK, 2048, G, bid);
            epi::Gates E{(bf16_t*)(F.ws + WS_Z + Z_RG), (bf16_t*)(F.ws + WS_Z + Z_G2)};
            pg8::gemm_phase(F.lds, F.tid, F.ws, g, S, E);
            SEAM(pb + 4);
        }
        if (PHON(6) && IN(pb + 5)) { PH_BEGIN();
            pg8::Gemm g{(const bf16_t*)(F.ws + WS_Z + Z_QB), (bf16_t*)(F.ws + WS_W) + W_PN / 2 + (size_t)l * 1024 * 512, 512, 512, (const bf16_t*)(F.ws + WS_Z + Z_ORW), (bf16_t*)(F.ws + WS_W) + W_PR / 2 + (size_t)l * 1024 * 512};
            pg8::PairOrder S; S.g.init(NTOK, 1024, G, bid);
            epi::PairGate E{(const bf16_t*)(F.ws + WS_Z + Z_RG), (bf16_t*)(F.ws + WS_Z + Z_G2)};
            pg8::gemm_phase(F.lds, F.tid, F.ws, g, S, E);
            SEAM(pb + 5);
        }
        if (PHON(7) && IN(pb + 6)) { PH_BEGIN();
            pg8::Gemm g{(const bf16_t*)(F.ws + WS_Z + Z_G2), (bf16_t*)(F.ws + WS_W) + W_OUT / 2 + (size_t)l * 1024 * 1024, 1024, 1024, nullptr, nullptr}; pg8::GridOrder S; S.init(NTOK, 1024, G, bid);
            epi::Resid E{(const bf16_t*)(F.ws + WS_XB), (bf16_t*)(F.ws + WS_Z + Z_RG), 1.f, false};
            pg8::gemm_phase(F.lds, F.tid, F.ws, g, S, E);
            SEAM(pb + 6);
        }
        if (PHON(8) && IN(pb + 7)) { PH_BEGIN(); ln_phase(F, (const bf16_t*)(F.ws + WS_Z + Z_RG), inp(F, I_LN1G) + (size_t)l * DM, inp(F, I_LN1B) + (size_t)l * DM, false); SEAM(pb + 7); }
        if (PHON(9) && IN(pb + 8)) { PH_BEGIN();
            pg8::Gemm g{(bf16_t*)(F.ws + WS_XB), (bf16_t*)(F.ws + WS_W) + W_XQ / 2 + (size_t)l * 512 * 1024, 1024, 1024, nullptr, nullptr}; pg8::GridOrder S; S.init(NTOK, 512, G, bid);
            epi::StoreBf16 E{(bf16_t*)(F.ws + WS_Z + Z_QX), 512, 2, XQSCALE};
            pg8::gemm_phase(F.lds, F.tid, F.ws, g, S, E);
            SEAM(pb + 8);
        }
        if (PHON(10) && IN(pb + 9)) { PH_BEGIN(); for (int it = bid; it < 256; it += G) xattn_lds_item(F, l, it); SEAM(pb + 9); }
        if (PHON(11) && IN(pb + 10)) { PH_BEGIN();
            pg8::Gemm g{(const bf16_t*)(F.ws + WS_Z + Z_QX), (bf16_t*)(F.ws + WS_W) + W_XO / 2 + (size_t)l * 1024 * 512, 512, 512, nullptr, nullptr}; pg8::GridOrder S; S.init(NTOK, 1024, G, bid);
            epi::Resid E{(const bf16_t*)(F.ws + WS_XB), (bf16_t*)(F.ws + WS_Z + Z_G2), 1.f, false};
            pg8::gemm_phase(F.lds, F.tid, F.ws, g, S, E);
            SEAM(pb + 10);
        }
        if (PHON(12) && IN(pb + 11)) { PH_BEGIN(); ln2_route_phase(F, args, l, (const bf16_t*)(F.ws + WS_Z + Z_G2), false); SEAM(pb + 11); }
        if (PHON(14) && IN(pb + 13)) { PH_BEGIN();
            moe_tables(F, l, PE);
            pg8::Gemm g{(const bf16_t*)(F.ws + WS_XB), (bf16_t*)(F.ws + WS_W) + W_MGU / 2 + (size_t)l * 16 * 1024 * 1024, 1024, 1024, nullptr, nullptr}; pg8::MoeOrder S{PE, G, bid};
            epi::MoeGU E{(bf16_t*)(F.ws + WS_Z + Z_H)};
            pg8::gemm_phase<epi::MoeGU, pg8::MoeOrder, true>(F.lds, F.tid, F.ws, g, S, E, (const int*)(F.ws + WS_TAB + TB_LIST), PE);
            SEAM(pb + 13);
        }
        if (PHON(15) && IN(pb + 14)) { PH_BEGIN();
            moe_tables(F, l, PE);
            pg8::Gemm g{(const bf16_t*)(F.ws + WS_Z + Z_H), (bf16_t*)(F.ws + WS_W) + W_MD / 2 + (size_t)l * 16 * 1024 * 512, 512, 512, nullptr, nullptr}; pg8::MoeOrder S{PE, G, bid};
            epi::StoreBf16 E{(bf16_t*)(F.ws + WS_Z + Z_XS), 1024, 4, 1.f};
            pg8::gemm_phase(F.lds, F.tid, F.ws, g, S, E);
            SEAM(pb + 14);
        }
        if (PHON(16) && IN(pb + 15)) { PH_BEGIN();
            ln3_phase(F, args, l, X, l + 1 == NLAYER, l + 1 < NLAYER);
            SEAM(pb + 15);
        }
        return false;
}

__global__ void __launch_bounds__(512, 2) fwd_kernel(Args args) {
    extern __shared__ __attribute__((aligned(16))) unsigned char lds_raw[];
    Frame F;
    F.lds = (LAS unsigned char*)lds_raw; F.tid = threadIdx.x; F.lane = F.tid & 63; F.wave = __builtin_amdgcn_readfirstlane(F.tid >> 6); F.G = gridDim.x; F.bid = blockIdx.x; F.ws = args.ws;
    for (int u = F.tid; u < (LDS_BYTES - LDSCTL_OFF) / 4; u += 512) ((LAS unsigned*)(F.lds + LDSCTL_OFF))[u] = 0u;
    __syncthreads();
    if (F.tid < 84) ((LAS unsigned*)(F.lds + PT_OFF))[F.tid] = ((const unsigned __attribute__((address_space(4)))*)__builtin_amdgcn_kernarg_segment_ptr())[F.tid];
    __syncthreads();
    volatile LAS unsigned* MISC = (volatile LAS unsigned*)(F.lds + MISC_OFF);
    XcdBarrier bar; bar.bar = (unsigned*)(F.ws + WS_CTL) + CW_BAR; bar.x = 0; bar.st = nullptr;
    if (!MK_SPLIT) bar = xcd_barrier_post((unsigned*)(F.ws + WS_CTL) + CW_BAR, MISC + 8);
#if MK_SPLIT
    const int lo = args.ph_lo, hi = args.ph_hi;
#endif
    float* X = args.out;
    LAS int* PE = (LAS int*)(F.lds + LDSCTL_OFF);
    const int G = F.G, bid = F.bid;

    if (PHON(0) && IN(0)) { prologue(F, args); SEAM(0); }

    if (layer_body<0>(F, args, X, bar, PE, G, bid)) return;
    if (layer_body<1>(F, args, X, bar, PE, G, bid)) return;
#undef IN
#undef SEAM
}

extern "C" void kernel_launch(void* const* d_in, const int* in_sizes, int n_in, void* d_out, int out_size, void* d_ws, size_t ws_size, hipStream_t stream) {
    static int grid = 0;
    if (grid == 0) {
        if (n_in != 42 || out_size != NTOK * DM || ws_size < WS_END) { fprintf(stderr, "kernel_launch: unexpected problem (n_in %d, out %d, ws %zu < %zu)\n", n_in, out_size, ws_size, (size_t)WS_END); grid = -1; return; }
        int dev = 0, cus = 0, per_cu = 0;
        if (hipGetDevice(&dev) != hipSuccess || hipDeviceGetAttribute(&cus, hipDeviceAttributeMultiprocessorCount, dev) != hipSuccess) { grid = -1; return; }
        if (hipFuncSetAttribute((const void*)fwd_kernel, hipFuncAttributeMaxDynamicSharedMemorySize, LDS_BYTES) != hipSuccess) { fprintf(stderr, "kernel_launch: hipFuncSetAttribute failed\n"); grid = -1; return; }
        if (hipOccupancyMaxActiveBlocksPerMultiprocessor(&per_cu, (const void*)fwd_kernel, 512, LDS_BYTES) != hipSuccess || per_cu < 1) fprintf(stderr, "kernel_launch: occupancy query says %d\n", per_cu);
        (void)hipGetLastError();
        grid = cus;
        if (grid < 64 || (grid % 8) != 0) { fprintf(stderr, "kernel_launch: unsupported CU count %d\n", cus); grid = -1; return; }
    }
    if (grid < 0) return;
    (void)hipMemsetAsync((char*)d_ws + WS_CTL, 0, CTL_ZERO_BYTES, stream);
    Args a{};
    for (int i = 0; i < 42; ++i) a.in[i] = (const float*)d_in[i];
    a.out = (float*)d_out; a.ws = (unsigned char*)d_ws;
#if MK_SPLIT
    for (int p = 0; p < N_PHASES; ++p) { a.ph_lo = p; a.ph_hi = p + 1; hipLaunchKernelGGL(fwd_kernel, dim3(grid), dim3(512), LDS_BYTES, stream, a); }
#else
    a.ph_lo = 0; a.ph_hi = N_PHASES;
    hipLaunchKernelGGL(fwd_kernel, dim3(grid), dim3(512), LDS_BYTES, stream, a);
#endif
}
```

```cpp
#include <hip/hip_runtime.h>
#include <cstdio>
#include <cstdint>

#define PROBE_ID -1
#define PROBE2_A -1
#define PROBE2_B -1
#define PROBE_WG 0
#define PROBE_L 1
#define LAS __attribute__((address_space(3)))
#define GAS __attribute__((address_space(1)))
typedef unsigned short bf16_t;
typedef short bf16x8 __attribute__((ext_vector_type(8)));
typedef float f32x4 __attribute__((ext_vector_type(4)));
typedef float f32x2 __attribute__((ext_vector_type(2)));
typedef unsigned u32x4 __attribute__((ext_vector_type(4)));
typedef unsigned u32x2 __attribute__((ext_vector_type(2)));
typedef GAS unsigned gu32;

constexpr int NB = 4, SEQ = 8192, DM = 1024, NTOK = NB * SEQ, NLAYER = 2;
constexpr int IN_COLS = 5144;
constexpr int NEXP = 16, EFF = 512;
constexpr int MEMLEN = 256;
constexpr float LOG2E = 1.4426950408889634f;
constexpr float QSCALE = 0.125f * LOG2E;
constexpr float XQSCALE = 0.08838834764831845f * LOG2E;
constexpr float DN_ALPHA = 1.4142135623730951f;
constexpr float LN_EPS = 1e-5f, GN_EPS = 64e-5f;
constexpr float NEGV = -60000.f, MINIT = -30000.f;

constexpr size_t MiB = 1u << 20;
constexpr size_t WS_CTL = 0, CTL_ZERO_BYTES = 64 * 1024;
constexpr size_t WS_TAB = 1 * MiB;
constexpr size_t TB_BK = 0;
constexpr size_t TB_CB = 4096;
constexpr size_t TB_GATE = 16384;
constexpr size_t TB_POS = TB_GATE + (size_t)NTOK * 2 * 4;
constexpr size_t TB_LIST = TB_POS + (size_t)NTOK * 2 * 4;
static_assert(TB_LIST + (size_t)NEXP * NTOK * 4 <= 3 * MiB, "TAB");
constexpr size_t WS_W = 4 * MiB;
constexpr size_t W_IN = 0;
constexpr size_t W_GT = W_IN + (size_t)2 * 3328 * 1024 * 2;
constexpr size_t W_PN = W_GT + (size_t)2 * 2048 * 1024 * 2;
constexpr size_t W_PR = W_PN + (size_t)2 * 1024 * 512 * 2;
constexpr size_t W_OUT = W_PR + (size_t)2 * 1024 * 512 * 2;
constexpr size_t W_XQ = W_OUT + (size_t)2 * 1024 * 1024 * 2;
constexpr size_t W_XKV = W_XQ + (size_t)2 * 512 * 1024 * 2;
constexpr size_t W_XO = W_XKV + (size_t)2 * 1024 * 1024 * 2;
constexpr size_t W_C1 = W_XO + (size_t)2 * 1024 * 512 * 2;
constexpr size_t W_C2 = W_C1 + (size_t)2 * 512 * 2048 * 2;
constexpr size_t W_MEM = W_C2 + (size_t)2 * 512 * 256 * 2;
constexpr size_t W_MGU = W_MEM + (size_t)1024 * 1024 * 2;
constexpr size_t W_MD = W_MGU + (size_t)2 * 16 * 1024 * 1024 * 2;
constexpr size_t W_END = W_MD + (size_t)2 * 16 * 1024 * 512 * 2;
static_assert(W_END <= 144 * MiB, "weights region");
constexpr size_t WS_XB = 148 * MiB;
constexpr size_t WS_VF = 212 * MiB;
constexpr size_t WS_XKV = 244 * MiB;
constexpr size_t WS_Z = 248 * MiB;
constexpr size_t Z_QB = 0;
constexpr size_t Z_KV6 = 32 * MiB;
constexpr size_t Z_RKV = 81 * MiB;
constexpr size_t Z_ZL = 177 * MiB;
constexpr size_t Z_GN = 193 * MiB;
constexpr size_t Z_VL = 197 * MiB;
constexpr size_t Z_HC = 199 * MiB;
constexpr size_t Z_KCMP = 203 * MiB;
constexpr size_t Z_VCMPT = Z_KCMP + 512 * 1024;
constexpr size_t Z_ORW = 204 * MiB;
constexpr size_t Z_ZLH = 197 * MiB;
constexpr size_t Z_VAB = 236 * MiB;
constexpr size_t Z_RG = 32 * MiB;
constexpr size_t Z_G2 = 96 * MiB;
constexpr size_t Z_QX = 32 * MiB;
constexpr size_t Z_XS = 0;
constexpr size_t Z_H = 136 * MiB;
constexpr size_t MOE_ROWS_MAX = 65536 + 16 * 256;
static_assert((size_t)MOE_ROWS_MAX * 1024 * 2 <= 136 * MiB && Z_H + (size_t)MOE_ROWS_MAX * 512 * 2 <= 240 * MiB, "moe arena");
constexpr size_t WS_RKH = WS_Z + 240 * MiB;
constexpr size_t WS_END = WS_RKH + 6 * MiB;
constexpr int CW_BAR = 1024;
constexpr int CW_LPR = 6144;
constexpr int CW_NSAQ = 6656;
constexpr int CW_CMP = 7168;
constexpr int CW_CNT = 8192;
static_assert((CW_CNT + 256) * 4 <= (int)CTL_ZERO_BYTES && (CW_BAR + 3456) <= CW_CNT, "CTL");

constexpr int RING_BYTES = 131072;
constexpr int LDSCTL_OFF = RING_BYTES, MISC_OFF = LDSCTL_OFF + 320;
constexpr int LDS_BYTES = 147456;
constexpr int UT_OFF = LDSCTL_OFF + 2048;

typedef __bf16 bf16x2_t __attribute__((ext_vector_type(2)));
__device__ __forceinline__ unsigned pk2(float lo, float hi) { f32x2 v = {lo, hi}; bf16x2_t b = __builtin_convertvector(v, bf16x2_t); return __builtin_bit_cast(unsigned, b); }
__device__ __forceinline__ unsigned f2bf(float f) { return pk2(f, f) & 0xffffu; }
__device__ __forceinline__ float rsqf(float x) { return __builtin_amdgcn_rsqf(x); }
__device__ __forceinline__ float bf2f(unsigned short b) { return __builtin_bit_cast(float, (unsigned)b << 16); }
__device__ __forceinline__ float bflo(unsigned w) { return __builtin_bit_cast(float, w << 16); }
__device__ __forceinline__ float bfhi(unsigned w) { return __builtin_bit_cast(float, w & 0xffff0000u); }
__device__ __forceinline__ float ex2(float x) { return __builtin_amdgcn_exp2f(x); }
__device__ __forceinline__ float rcpf(float x) { return __builtin_amdgcn_rcpf(x); }
__device__ __forceinline__ float sigmoidf_(float x) { return rcpf(1.f + ex2(-x * LOG2E)); }
__device__ __forceinline__ float tanhf_(float x) { return 2.f * sigmoidf_(2.f * x) - 1.f; }
__device__ __forceinline__ float gelu_tanh(float x) { return x * sigmoidf_(1.5957691216057308f * (x + 0.044715f * x * x * x)); }
template <int CTRL> __device__ __forceinline__ float dppf(float v) {
    return __builtin_bit_cast(float, __builtin_amdgcn_update_dpp(0, __builtin_bit_cast(int, v), CTRL, 0xF, 0xF, true));
}
__device__ __forceinline__ float red4(float v) { v += dppf<0xB1>(v); v += dppf<0x4E>(v); return v; }
__device__ __forceinline__ float red8(float v) { v = red4(v); v += dppf<0x141>(v); return v; }
__device__ __forceinline__ float red16(float v) { v = red8(v); v += dppf<0x140>(v); return v; }
__device__ __forceinline__ float wave_sum(float v) {
    v = red16(v);
    v += __builtin_bit_cast(float, __builtin_amdgcn_update_dpp(0, __builtin_bit_cast(int, v), 0x142, 0xA, 0xF, false));
    v += __builtin_bit_cast(float, __builtin_amdgcn_update_dpp(0, __builtin_bit_cast(int, v), 0x143, 0xC, 0xF, false));
    return __builtin_bit_cast(float, __builtin_amdgcn_readlane(__builtin_bit_cast(int, v), 63));
}
#define LDS_WAIT() asm volatile("s_waitcnt lgkmcnt(0)" ::: "memory")
#define VM_WAIT() asm volatile("s_waitcnt vmcnt(0)" ::: "memory")
#define RLX_AGENT __ATOMIC_RELAXED, __HIP_MEMORY_SCOPE_AGENT

namespace pg8 {
constexpr int BM = 256, BK = 64, HALF = 128, HTB = HALF * BK * 2, STAGE_BYTES = 8 * HTB, NXCD = 8, WGM = 8;
__host__ __device__ __forceinline__ int lds_byte(int r, int c) { const int st = (r >> 4) * 2 + (c >> 5), rr = r & 15, cc = c & 31, ob = rr * 64 + cc * 2; return st * 1024 + (ob ^ (((ob >> 9) & 1) << 5)); }
__host__ __device__ __forceinline__ void stage_rc(int b, int& R, int& C) { const int st = b / 1024, sb = b % 1024, swz = sb ^ (((sb >> 9) & 1) << 5); R = (st >> 1) * 16 + swz / 64; C = (st & 1) * 32 + (swz % 64) / 2; }
__host__ __device__ __forceinline__ int perm32(int rho) { const int n = rho >> 4, i = rho & 15; return 8 * (i >> 2) + 4 * n + (i & 3); }

struct Unit { int pm, pn, sel; };
struct Gemm { const bf16_t* A; const bf16_t* Bt; int lda, K; const bf16_t* A2; const bf16_t* Bt2; };

struct GridOrder {
    int nM, nN, nwg, G, c;
    __device__ void init(int M, int N, int G_, int c_) { nM = M / BM; nN = N / BM; nwg = nM * nN; G = G_; c = c_; }
    __device__ bool tile(long L, Unit& u) const {
        if (L >= nwg || c < 0) return false;
        int wgid = (int)L; { const int q = nwg / NXCD, r = nwg % NXCD, xcd = wgid % NXCD, off = wgid / NXCD; wgid = (xcd < r ? xcd * (q + 1) : r * (q + 1) + (xcd - r) * q) + off; }
        const int nig = WGM * nN, gid = wgid / nig, fm = gid * WGM, gsz = (nM - fm) < WGM ? (nM - fm) : WGM;
        u.pm = fm + ((wgid % nig) % gsz); u.pn = (wgid % nig) / gsz; u.sel = 0; return true;
    }
    __device__ bool next(int i, Unit& u) const { return tile((long)i * G + c, u); }
};
struct PairOrder {
    GridOrder g;
    __device__ bool next(int i, Unit& u) const { const bool ok = g.tile((long)(i >> 1) * g.G + g.c, u); u.sel = i & 1; return ok; }
};
struct RowOrder {
    int nM, per, G, c;
    __device__ bool next(int i, Unit& u) const { const long L = (long)i * G + c; if (L >= nM || c < 0) return false; u.pm = (int)L; u.pn = u.pm / per; u.sel = 0; return true; }
};
struct MoeOrder {
    const LAS int* pe;
    int G, c;
    __device__ bool next(int i, Unit& u) const {
        const long L = (long)i * G + c; const int total = pe[15] * 4; if (L >= total) return false;
        const int gt = (int)(L >> 2), pl = (int)(L & 3); int e = 0;
#pragma unroll
        for (int k = 0; k < 15; ++k) e += (gt >= pe[k]) ? 1 : 0;
        u.pm = gt; u.pn = e * 4 + pl; u.sel = 0; return true;
    }
};

__device__ __forceinline__ unsigned cvt_pk_bf16(float lo, float hi) { return pk2(lo, hi); }
__device__ __forceinline__ u32x4 pack8(const f32x4& a, const f32x4& b) { u32x4 w; w.x = cvt_pk_bf16(a[0], a[1]); w.y = cvt_pk_bf16(a[2], a[3]); w.z = cvt_pk_bf16(b[0], b[1]); w.w = cvt_pk_bf16(b[2], b[3]); return w; }

template <class Epi, class Sched, bool GATHER = false>
__device__ __forceinline__ void gemm_phase(LAS unsigned char* lds, const int tid, const unsigned char* wsbase, const Gemm g, const Sched& S, const Epi& E, const int* glist = nullptr, const LAS int* PEt = nullptr) {
    const int wid = __builtin_amdgcn_readfirstlane(tid >> 6), lane = tid & 63, wr = wid >> 2, wc = wid & 3, fr = lane & 15, fq = lane >> 4;
    const int K = g.K, nt = K / BK, lda = g.lda;
    const __amdgpu_buffer_rsrc_t rsrc = __builtin_amdgcn_make_buffer_rsrc((void*)wsbase, 0, 0x7ffffff0, 0x00020000);
    const unsigned oA0 = (unsigned)((const unsigned char*)g.A - wsbase), oB0 = (unsigned)((const unsigned char*)g.Bt - wsbase);
    const unsigned oA1 = g.A2 ? (unsigned)((const unsigned char*)g.A2 - wsbase) : oA0, oB1 = g.Bt2 ? (unsigned)((const unsigned char*)g.Bt2 - wsbase) : oB0;
    unsigned voffA[2], voffB[2]; int pR[2], pC[2];
#pragma unroll
    for (int i = 0; i < 2; ++i) { int R, C; stage_rc(tid * 16 + i * 8192, R, C); const int Rb = (R & ~31) + perm32(R & 31);
        voffA[i] = (unsigned)(R * lda + C) * 2u; voffB[i] = (unsigned)(Rb * K + C) * 2u; pR[i] = R; pC[i] = C; }
    const unsigned kstep = (unsigned)(BK * 2);
    const unsigned hstepA = (unsigned)HALF * (unsigned)lda * 2u, hstepB = (unsigned)HALF * (unsigned)K * 2u;
    const unsigned tstepA = 2u * hstepA, tstepB = 2u * hstepB;
    const unsigned ldsw = (unsigned)wid * 1024u;
    const int aoff = lds_byte(wr * 64 + fr, fq * 8), boff = lds_byte(wc * 32 + fr, fq * 8);
#define PG8_SA(b, h) (((b) * 2 + (h)) * HTB)
#define PG8_SB(b, h) ((4 + (b) * 2 + (h)) * HTB)
#define PG8_STAGE(bufoff, sbase, voff) do { _Pragma("unroll") for (int _i = 0; _i < 2; ++_i) \
        __builtin_amdgcn_raw_ptr_buffer_load_lds(rsrc, (LAS void*)(lds + (bufoff) + ldsw + _i * 8192), 16, (int)(voff)[_i], (int)(sbase), 0, 0); } while (0)
#define PG8_LDA(dst, b, h) do { _Pragma("unroll") for (int m = 0; m < 4; ++m) _Pragma("unroll") for (int k = 0; k < 2; ++k) dst[m][k] = *(const LAS bf16x8*)(lds + PG8_SA(b, h) + aoff + m * 2048 + k * 1024); } while (0)
#define PG8_LDB(dst, b, h) do { _Pragma("unroll") for (int n = 0; n < 2; ++n) _Pragma("unroll") for (int k = 0; k < 2; ++k) dst[n][k] = *(const LAS bf16x8*)(lds + PG8_SB(b, h) + boff + n * 2048 + k * 1024); } while (0)
#define PG8_MMA(ai, bj, At, Bt) do { __builtin_amdgcn_s_setprio(1); _Pragma("unroll") for (int m = 0; m < 4; ++m) _Pragma("unroll") for (int n = 0; n < 2; ++n) _Pragma("unroll") for (int k = 0; k < 2; ++k) \
        acc[ai][bj][m][n] = __builtin_amdgcn_mfma_f32_16x16x32_bf16(Bt[n][k], At[m][k], acc[ai][bj][m][n], 0, 0, 0); __builtin_amdgcn_s_setprio(0); } while (0)
#define PG8_WAIT_V(n) asm volatile("s_waitcnt vmcnt(" #n ")" ::: "memory")
#define PG8_WAIT_L(n) asm volatile("s_waitcnt lgkmcnt(" #n ")" ::: "memory")
#define PG8_BAR __builtin_amdgcn_s_barrier()
#define PG8_SCHED __builtin_amdgcn_sched_barrier(0)
    LAS int* UT = (LAS int*)(lds + UT_OFF);
    __syncthreads();
    if (tid == 0) { int n = 0; Unit u; while (n < 31 && S.next(n, u)) { UT[4 * n] = u.pm; UT[4 * n + 1] = u.pn; UT[4 * n + 2] = u.sel; ++n; } UT[127] = n; }
    __syncthreads();
    const int nunits = __builtin_amdgcn_readfirstlane(UT[127]);
#define UT_GET(i, u) ((i) < nunits ? ((u).pm = __builtin_amdgcn_readfirstlane(UT[4 * (i)]), (u).pn = __builtin_amdgcn_readfirstlane(UT[4 * (i) + 1]), (u).sel = __builtin_amdgcn_readfirstlane(UT[4 * (i) + 2]), true) : false)
    Unit cur, nxt; int ui = 0;
    if (!UT_GET(0, cur)) return;
    unsigned gc[2][2], gn[2][2];
#define PG8_GATH(dst, u) do { if constexpr (GATHER) { const int e_ = (u).pn >> 2, b_ = PEt[32 + e_], c_ = PEt[16 + e_]; \
        _Pragma("unroll") for (int h_ = 0; h_ < 2; ++h_) _Pragma("unroll") for (int i_ = 0; i_ < 2; ++i_) { const int s_ = (u).pm * BM + h_ * HALF + pR[i_] - b_; \
            const int tok_ = (s_ < c_) ? (glist[(size_t)e_ * NTOK + s_] >> 1) : 0; dst[h_][i_] = (unsigned)(tok_ * lda + pC[i_]) * 2u; } } } while (0)
#define PG8_STAGE_A(bufoff, half, plainoff, kt, nextu) do { if constexpr (GATHER) { unsigned v_[2]; v_[0] = (nextu) ? gn[half][0] : gc[half][0]; v_[1] = (nextu) ? gn[half][1] : gc[half][1]; \
        PG8_STAGE(bufoff, oA0 + (unsigned)(kt) * kstep, v_); } else { PG8_STAGE(bufoff, plainoff, voffA); } } while (0)
    PG8_GATH(gc, cur);
    f32x4 acc[2][2][4][2];
#pragma unroll
    for (int a = 0; a < 2; ++a)
#pragma unroll
        for (int b = 0; b < 2; ++b)
#pragma unroll
            for (int m = 0; m < 4; ++m)
#pragma unroll
                for (int n = 0; n < 2; ++n) acc[a][b][m][n] = (f32x4){0.f, 0.f, 0.f, 0.f};
    bf16x8 At[4][2], B0[2][2], B1[2][2];
    unsigned cA = (cur.sel ? oA1 : oA0) + (unsigned)cur.pm * tstepA, cB = (cur.sel ? oB1 : oB0) + (unsigned)cur.pn * tstepB;
    PG8_STAGE(PG8_SB(0, 0), cB, voffB); PG8_STAGE(PG8_SB(0, 1), cB + hstepB, voffB); PG8_STAGE_A(PG8_SA(0, 0), 0, cA, 0, false); PG8_STAGE_A(PG8_SA(0, 1), 1, cA + hstepA, 0, false);
    if (wr == 1) PG8_BAR;
    PG8_WAIT_V(2); PG8_BAR;
    PG8_STAGE(PG8_SB(1, 0), cB + kstep, voffB); PG8_STAGE_A(PG8_SA(1, 0), 0, cA + kstep, 1, false); PG8_STAGE(PG8_SB(1, 1), cB + hstepB + kstep, voffB);
    PG8_WAIT_V(6); PG8_BAR;
    for (;;) {
        const bool has_next = UT_GET(ui + 1, nxt);
        if (has_next) PG8_GATH(gn, nxt);
        const unsigned nA = has_next ? (nxt.sel ? oA1 : oA0) + (unsigned)nxt.pm * tstepA : cA, nB = has_next ? (nxt.sel ? oB1 : oB0) + (unsigned)nxt.pn * tstepB : cB;
        for (int t = 0; t < nt; t += 2) {
            const bool last = (t == nt - 2);
            const unsigned a1 = cA + (unsigned)(t + 1) * kstep;
            const unsigned a2 = last ? nA : cA + (unsigned)(t + 2) * kstep, b2 = last ? nB : cB + (unsigned)(t + 2) * kstep;
            const unsigned a3 = a2 + kstep, b3 = b2 + kstep;
            PG8_LDB(B0, 0, 0); PG8_LDB(B1, 0, 1); PG8_SCHED; PG8_LDA(At, 0, 0); PG8_STAGE_A(PG8_SA(1, 1), 1, a1 + hstepA, t + 1, false);
            PG8_WAIT_V(8); PG8_WAIT_L(0); PG8_BAR; PG8_MMA(0, 0, At, B0); PG8_MMA(0, 1, At, B1); PG8_BAR; PG8_SCHED;
            PG8_LDA(At, 0, 1); PG8_STAGE(PG8_SB(0, 0), b2, voffB); PG8_STAGE(PG8_SB(0, 1), b2 + hstepB, voffB); PG8_STAGE_A(PG8_SA(0, 0), 0, a2, (last ? 0 : t + 2), (last && has_next));
            PG8_WAIT_V(8); PG8_WAIT_L(0); PG8_BAR; PG8_MMA(1, 0, At, B0); PG8_MMA(1, 1, At, B1); PG8_BAR; PG8_SCHED;
            PG8_LDB(B0, 1, 0); PG8_LDB(B1, 1, 1); PG8_SCHED; PG8_LDA(At, 1, 0); PG8_STAGE_A(PG8_SA(0, 1), 1, a2 + hstepA, (last ? 0 : t + 2), (last && has_next));
            PG8_WAIT_V(8); PG8_WAIT_L(0); PG8_BAR; PG8_MMA(0, 0, At, B0); PG8_MMA(0, 1, At, B1); PG8_BAR; PG8_SCHED;
            PG8_LDA(At, 1, 1); PG8_STAGE(PG8_SB(1, 0), b3, voffB); PG8_STAGE(PG8_SB(1, 1), b3 + hstepB, voffB); PG8_STAGE_A(PG8_SA(1, 0), 0, a3, (last ? 1 : t + 3), (last && has_next));
            PG8_WAIT_V(8); PG8_WAIT_L(0); PG8_BAR; PG8_MMA(1, 0, At, B0); PG8_MMA(1, 1, At, B1); PG8_BAR; PG8_SCHED;
        }
        if (wr == 0) PG8_BAR;
        const bool keep = E(acc, cur, wr, wc, fr, fq);
        if (!has_next) break;
        if (!keep) {
#pragma unroll
        for (int a = 0; a < 2; ++a)
#pragma unroll
            for (int b = 0; b < 2; ++b)
#pragma unroll
                for (int m = 0; m < 4; ++m)
#pragma unroll
                    for (int n = 0; n < 2; ++n) acc[a][b][m][n] = (f32x4){0.f, 0.f, 0.f, 0.f};
        }
        cur = nxt; cA = nA; cB = nB; ++ui;
        if constexpr (GATHER) { gc[0][0] = gn[0][0]; gc[0][1] = gn[0][1]; gc[1][0] = gn[1][0]; gc[1][1] = gn[1][1]; }
        if (wr == 1) PG8_BAR;
    }
    PG8_WAIT_V(0);
    PG8_BAR;
#undef UT_GET
#undef PG8_GATH
#undef PG8_STAGE_A
#undef PG8_SA
#undef PG8_SB
#undef PG8_STAGE
#undef PG8_LDA
#undef PG8_LDB
#undef PG8_MMA
#undef PG8_WAIT_V
#undef PG8_WAIT_L
#undef PG8_BAR
#undef PG8_SCHED
}
}

namespace epi {
using pg8::Unit; using pg8::pack8; using pg8::HALF; using pg8::BM;
typedef f32x4 Acc[2][2][4][2];
#define EPI_FENCE ({ asm volatile("" ::: "memory"); 0; })
#define EPI_LOOP for (int ai = 0; ai < 2; ++ai) _Pragma("unroll") for (int m = 0; m < 4; ++m, (void)EPI_FENCE) _Pragma("unroll") for (int bj = 0; bj < 2; ++bj)
#define EPI_ROW (u.pm * BM + ai * HALF + wr * 64 + m * 16 + fr)
#define EPI_COL (bj * HALF + wc * 32 + 8 * fq)

struct InProj {
    bf16_t* qb; bf16_t* kv6; bf16_t* zl; bf16_t* rkv; float* gn; bf16_t* vab; bf16_t* zlh; bf16_t* rkh;
    __device__ __forceinline__ bool operator()(Acc& acc, const Unit& u, int wr, int wc, int fr, int fq) const {
        const int pn = u.pn; const unsigned r0 = (unsigned)(u.pm * BM + wr * 64 + fr);
        if (pn < 2 || pn >= 5) {
            if (pn < 12) {
                unsigned char* base; unsigned ldc; float sc = 1.f;
                if (pn < 2) { base = (unsigned char*)(qb + pn * 256); ldc = 512; sc = QSCALE; } else if (pn == 5) { base = (unsigned char*)zl; ldc = 256; } else { base = (unsigned char*)(rkv + (pn - 6) * 256); ldc = 1536; }
                const unsigned o0 = (r0 * ldc + (unsigned)(wc * 32 + 8 * fq)) * 2u;
#pragma unroll
                EPI_LOOP { const unsigned o = o0 + ((unsigned)(ai * HALF + m * 16) * ldc + (unsigned)(bj * HALF)) * 2u; *(u32x4*)(base + o) = pack8(acc[ai][bj][m][0] * sc, acc[ai][bj][m][1] * sc); }
                if (pn >= 6 && fr == 15) {
                    unsigned char* hb = (unsigned char*)(rkh + (pn - 6) * 256); const unsigned h0 = ((r0 >> 4) * 1536u + (unsigned)(wc * 32 + 8 * fq)) * 2u;
#pragma unroll
                    EPI_LOOP { const unsigned o = h0 + ((unsigned)(ai * 8 + m) * 1536u + (unsigned)(bj * HALF)) * 2u; *(u32x4*)(hb + o) = pack8(acc[ai][bj][m][0], acc[ai][bj][m][1]); } }
                if (pn == 5 && fr == 15) {
                    unsigned char* hb = (unsigned char*)zlh; const unsigned h0 = ((r0 >> 4) * 256u + (unsigned)(wc * 32 + 8 * fq)) * 2u;
#pragma unroll
                    EPI_LOOP { const unsigned o = h0 + ((unsigned)(ai * 8 + m) * 256u + (unsigned)(bj * HALF)) * 2u; *(u32x4*)(hb + o) = pack8(acc[ai][bj][m][0], acc[ai][bj][m][1]); } }
            } else if (wc == 1 || wc == 2) {
                unsigned char* base = (unsigned char*)vab; const unsigned o0 = (r0 * 64u + (unsigned)((wc - 1) * 32 + 8 * fq)) * 2u;
#pragma unroll
                for (int ai = 0; ai < 2; ++ai)
#pragma unroll
                    for (int m = 0; m < 4; ++m, (void)EPI_FENCE) { const unsigned o = o0 + (unsigned)(ai * HALF + m * 16) * 128u; *(u32x4*)(base + o) = pack8(acc[ai][0][m][0], acc[ai][0][m][1]); }
            } else if (wc == 0 && fq < 3) {
                unsigned char* base = (unsigned char*)gn; const unsigned o0 = (r0 * 32u + (unsigned)(8 * fq)) * 4u;
#pragma unroll
                for (int ai = 0; ai < 2; ++ai)
#pragma unroll
                    for (int m = 0; m < 4; ++m, (void)EPI_FENCE) { const unsigned o = o0 + (unsigned)(ai * HALF + m * 16) * 128u; const f32x4 a = acc[ai][0][m][0], b = acc[ai][0][m][1]; f32x4 x, y;
#pragma unroll
                        for (int e = 0; e < 4; ++e) { x[e] = sigmoidf_(a[e]); y[e] = sigmoidf_(b[e]); }
                        *(f32x4*)(base + o) = x; *(f32x4*)(base + o + 16) = y; }
            }
        } else {
            const int b = u.pm >> 5, gg = wc >> 1, d = (wc & 1) * 32 + 8 * fq; const unsigned t0 = r0 & 8191u;
#pragma unroll
            for (int bj = 0; bj < 2; ++bj) { const int which = 2 * (pn - 2) + bj; unsigned char* base = (unsigned char*)(kv6 + ((size_t)((which * 4 + b) * 2 + gg) * 8192) * 64);
                if (which == 3 || which == 5) {
                    const unsigned o0 = ((unsigned)d * 8192u + t0) * 2u;
#pragma unroll
                    for (int ai = 0; ai < 2; ++ai)
#pragma unroll
                        for (int m = 0; m < 4; ++m, (void)EPI_FENCE) { const unsigned o = o0 + (unsigned)(ai * HALF + m * 16) * 2u;
#pragma unroll
                            for (int e = 0; e < 8; ++e) *(bf16_t*)(base + o + (unsigned)e * 16384u) = (bf16_t)f2bf(acc[ai][bj][m][e >> 2][e & 3]); }
                } else {
                    const unsigned o0 = (t0 * 64u + (unsigned)d) * 2u;
#pragma unroll
                    for (int ai = 0; ai < 2; ++ai)
#pragma unroll
                        for (int m = 0; m < 4; ++m, (void)EPI_FENCE) { const unsigned o = o0 + (unsigned)(ai * HALF + m * 16) * 128u; *(u32x4*)(base + o) = pack8(acc[ai][bj][m][0], acc[ai][bj][m][1]); }
                }
            }
        }
        return false;
    }
};
struct Gates {
    bf16_t* rg; bf16_t* g2;
    __device__ __forceinline__ bool operator()(Acc& acc, const Unit& u, int wr, int wc, int fr, int fq) const {
#pragma unroll
        for (int ai = 0; ai < 2; ++ai)
#pragma unroll
            for (int m = 0; m < 4; ++m, (void)EPI_FENCE) { const int r = u.pm * BM + ai * HALF + wr * 64 + m * 16 + fr, c = u.pn * 128 + wc * 32 + 8 * fq;
                f32x4 ra, rb, ga, gb;
#pragma unroll
                for (int e = 0; e < 4; ++e) { const float s1a = sigmoidf_(acc[ai][0][m][0][e]), s2a = sigmoidf_(acc[ai][1][m][0][e]), s1b = sigmoidf_(acc[ai][0][m][1][e]), s2b = sigmoidf_(acc[ai][1][m][1][e]);
                    ga[e] = s2a; gb[e] = s2b; ra[e] = s1a * rcpf(s2a); rb[e] = s1b * rcpf(s2b); }
                *(u32x4*)(rg + (size_t)r * 1024 + c) = pack8(ra, rb); *(u32x4*)(g2 + (size_t)r * 1024 + c) = pack8(ga, gb); }
        return false;
    }
};
__device__ __forceinline__ void unpack8(const u32x4 w, f32x4& a, f32x4& b) { a[0] = bflo(w.x); a[1] = bfhi(w.x); a[2] = bflo(w.y); a[3] = bfhi(w.y); b[0] = bflo(w.z); b[1] = bfhi(w.z); b[2] = bflo(w.w); b[3] = bfhi(w.w); }
struct PairGate {
    const bf16_t* rg; bf16_t* g2;
    __device__ __forceinline__ bool operator()(Acc& acc, const Unit& u, int wr, int wc, int fr, int fq) const {
        if (u.sel == 0) {
#pragma unroll
            EPI_LOOP { const int r = EPI_ROW, c = u.pn * 256 + EPI_COL; f32x4 a, b; unpack8(*(const u32x4*)(rg + (size_t)r * 1024 + c), a, b); acc[ai][bj][m][0] *= a; acc[ai][bj][m][1] *= b; }
            return true;
        }
#pragma unroll
        EPI_LOOP { const int r = EPI_ROW, c = u.pn * 256 + EPI_COL; bf16_t* p = g2 + (size_t)r * 1024 + c; f32x4 a, b; unpack8(*(const u32x4*)p, a, b); *(u32x4*)p = pack8(acc[ai][bj][m][0] * a, acc[ai][bj][m][1] * b); }
        return false;
    }
};
struct Resid {
    const bf16_t* xin; bf16_t* out; float ysc; bool dry;
    __device__ __forceinline__ bool operator()(Acc& acc, const Unit& u, int wr, int wc, int fr, int fq) const {
#pragma unroll
        EPI_LOOP { const int r = EPI_ROW, c = u.pn * 256 + EPI_COL; const size_t o = (size_t)r * 1024 + c; f32x4 x0, x1; unpack8(*(const u32x4*)(xin + o), x0, x1);
            if (!dry) *(u32x4*)(out + o) = pack8(x0 * DN_ALPHA + acc[ai][bj][m][0] * ysc, x1 * DN_ALPHA + acc[ai][bj][m][1] * ysc); }
        return false;
    }
};
struct StoreBf16 {
    bf16_t* O; int ldc; int nct; float scale;
    __device__ __forceinline__ bool operator()(Acc& acc, const Unit& u, int wr, int wc, int fr, int fq) const {
        const int ct = u.pn % nct;
#pragma unroll
        EPI_LOOP { const int r = EPI_ROW, c = ct * 256 + EPI_COL; *(u32x4*)(O + (size_t)r * ldc + c) = pack8(acc[ai][bj][m][0] * scale, acc[ai][bj][m][1] * scale); }
        return false;
    }
};
struct MemKV {
    bf16_t* kx; bf16_t* vxt;
    __device__ __forceinline__ bool operator()(Acc& acc, const Unit& u, int wr, int wc, int fr, int fq) const {
        const unsigned r0 = (unsigned)(u.pm * BM + wr * 64 + fr);
        if (u.pn < 2) {
            unsigned char* base = (unsigned char*)(kx + u.pn * 256); const unsigned o0 = (r0 * 512u + (unsigned)(wc * 32 + 8 * fq)) * 2u;
#pragma unroll
            EPI_LOOP { const unsigned o = o0 + ((unsigned)(ai * HALF + m * 16) * 512u + (unsigned)(bj * HALF)) * 2u; *(u32x4*)(base + o) = pack8(acc[ai][bj][m][0], acc[ai][bj][m][1]); }
        } else {
            const unsigned mm0 = (unsigned)(wr * 64 + fr);
#pragma unroll
            for (int bj = 0; bj < 2; ++bj) { const int h = 2 * (u.pn - 2) + bj; unsigned char* base = (unsigned char*)(vxt + ((size_t)(u.pm * 4 + h) * 128) * 256); const unsigned o0 = ((unsigned)(wc * 32 + 8 * fq) * 256u + mm0) * 2u;
#pragma unroll
                for (int ai = 0; ai < 2; ++ai)
#pragma unroll
                    for (int m = 0; m < 4; ++m, (void)EPI_FENCE) { const unsigned o = o0 + (unsigned)(ai * HALF + m * 16) * 2u;
#pragma unroll
                        for (int e = 0; e < 8; ++e) *(bf16_t*)(base + o + (unsigned)e * 512u) = (bf16_t)f2bf(acc[ai][bj][m][e >> 2][e & 3]); } }
        }
        return false;
    }
};
struct Cmp1 {
    bf16_t* hc; const float* bias;
    __device__ __forceinline__ bool operator()(Acc& acc, const Unit& u, int wr, int wc, int fr, int fq) const {
#pragma unroll
        EPI_LOOP { const int r = EPI_ROW, c = EPI_COL; const f32x4 b0 = *(const f32x4*)(bias + u.pn * 256 + c), b1 = *(const f32x4*)(bias + u.pn * 256 + c + 4); f32x4 x = acc[ai][bj][m][0] + b0, y = acc[ai][bj][m][1] + b1;
#pragma unroll
            for (int e = 0; e < 4; ++e) { x[e] = gelu_tanh(x[e]); y[e] = gelu_tanh(y[e]); }
            *(u32x4*)(hc + (size_t)r * 256 + c) = pack8(x, y); }
        return false;
    }
};
struct Cmp2 {
    bf16_t* kc; bf16_t* vct;
    __device__ __forceinline__ bool operator()(Acc& acc, const Unit& u, int wr, int wc, int fr, int fq) const {
        if (wc < 2) {
#pragma unroll
            for (int ai = 0; ai < 2; ++ai)
#pragma unroll
                for (int m = 0; m < 4; ++m, (void)EPI_FENCE) { const int r = u.pm * BM + ai * HALF + wr * 64 + m * 16 + fr, d = wc * 32 + 8 * fq, rr = r & 4095, slab = rr >> 9, i = rr & 511;
                    if (r < 4096) *(u32x4*)(kc + ((size_t)slab * 512 + i) * 64 + d) = pack8(acc[ai][0][m][0], acc[ai][0][m][1]);
                    else {
#pragma unroll
                        for (int e = 0; e < 8; ++e) vct[((size_t)slab * 64 + d + e) * 512 + i] = (bf16_t)f2bf(acc[ai][0][m][e >> 2][e & 3]); } }
        }
        return false;
    }
};
struct MoeGU {
    bf16_t* h;
    __device__ __forceinline__ bool operator()(Acc& acc, const Unit& u, int wr, int wc, int fr, int fq) const {
        const int ct = u.pn & 3;
#pragma unroll
        for (int ai = 0; ai < 2; ++ai)
#pragma unroll
            for (int m = 0; m < 4; ++m, (void)EPI_FENCE) { const int r = u.pm * BM + ai * HALF + wr * 64 + m * 16 + fr, c = ct * 128 + wc * 32 + 8 * fq; f32x4 x, y;
#pragma unroll
                for (int e = 0; e < 4; ++e) { const float g0 = acc[ai][0][m][0][e], g1 = acc[ai][0][m][1][e]; x[e] = g0 * sigmoidf_(g0) * acc[ai][1][m][0][e]; y[e] = g1 * sigmoidf_(g1) * acc[ai][1][m][1][e]; }
                *(u32x4*)(h + (size_t)r * 512 + c) = pack8(x, y); }
        return false;
    }
};
#undef EPI_LOOP
#undef EPI_FENCE
#undef EPI_ROW
#undef EPI_COL
}

#define XB_TMO      128
#define XB_XCNT(j)  (256  + 64 * (j))
#define XB_XSUB(j)  (1280 + 64 * (j))
#define XB_XGEN(j)  (2304 + 64 * (j))
#define XB_TOP      3328
#define XB_TOPGEN   3392
#define XCD_BAR_WORDS 3456
#define XB_SPIN_CAP (1u << 18)
__device__ __forceinline__ unsigned xb_ld(unsigned* p)              { return __hip_atomic_load(p, __ATOMIC_RELAXED, __HIP_MEMORY_SCOPE_AGENT); }
__device__ __forceinline__ unsigned xb_add(unsigned* p, unsigned v) { return __hip_atomic_fetch_add(p, v, __ATOMIC_RELAXED, __HIP_MEMORY_SCOPE_AGENT); }
__device__ __forceinline__ unsigned xb_xcc_id() { return (unsigned)__builtin_amdgcn_s_getreg((3 << 11) | 20) & 0xFu; }
#define XB_SPIN(cond, bar) do { unsigned _sp = 0; while (cond) { __builtin_amdgcn_s_sleep(1); \
    if ((++_sp & 255u) == 0u) { if (xb_ld(&(bar)[XB_TMO])) break; if (_sp > XB_SPIN_CAP) { atomicAdd(&(bar)[XB_TMO], 1u); break; } } } } while (0)
struct XcdBarrier { unsigned* bar; unsigned x; volatile LAS unsigned* st; };
__device__ __forceinline__ XcdBarrier xcd_barrier_post(unsigned* bar, volatile LAS unsigned* st) {
    XcdBarrier b; b.bar = bar; b.x = xb_xcc_id(); b.st = st;
    if (threadIdx.x == 0) (void)xb_add(&bar[XB_XCNT(b.x)], 1u);
    return b;
}
__device__ __forceinline__ void xcd_barrier_complete(unsigned* bar, unsigned x, unsigned& nloc, unsigned& nx) {
    const unsigned G = gridDim.x * gridDim.y * gridDim.z;
    unsigned sum, cnt, mine, sp = 0u;
    for (;;) {
        sum = 0u; cnt = 0u; mine = 0u;
#pragma unroll
        for (unsigned j = 0; j < 16; ++j) { const unsigned c = xb_ld(&bar[XB_XCNT(j)]); sum += c; cnt += (c > 0u) ? 1u : 0u; mine = (j == x) ? c : mine; }
        if (sum == G) break;
        __builtin_amdgcn_s_sleep(1);
        if ((++sp & 255u) == 0u) { if (xb_ld(&bar[XB_TMO])) break; if (sp > XB_SPIN_CAP) { atomicAdd(&bar[XB_TMO], 1u); break; } }
    }
    nloc = mine > 0u ? mine : 1u; nx = cnt > 0u ? cnt : 1u;
}
__device__ __forceinline__ void xcd_barrier(const XcdBarrier& b) {
    asm volatile("s_waitcnt vmcnt(0)" ::: "memory");
    __syncthreads();
    if (threadIdx.x == 0) {
        unsigned* bar = b.bar; const unsigned bx = xb_xcc_id();
        __builtin_amdgcn_s_waitcnt(0);
        unsigned nloc = b.st[0], nx = b.st[1];
        if (nloc == 0u) { xcd_barrier_complete(bar, bx, nloc, nx); b.st[0] = nloc; b.st[1] = nx; }
        const unsigned old = xb_add(&bar[XB_XSUB(bx)], 1u);
        const unsigned gen = old / nloc;
        if (old + 1u == (gen + 1u) * nloc) {
            __builtin_amdgcn_fence(__ATOMIC_RELEASE, "agent");
            asm volatile("s_waitcnt vmcnt(0)" ::: "memory");
            const unsigned og = xb_add(&bar[XB_TOP], 1u);
            const unsigned tg = og / nx;
            if (og + 1u == (tg + 1u) * nx) xb_add(&bar[XB_TOPGEN], 1u);
            else XB_SPIN(xb_ld(&bar[XB_TOPGEN]) == tg, bar);
            __builtin_amdgcn_fence(__ATOMIC_ACQUIRE, "agent");
            xb_add(&bar[XB_XGEN(bx)], 1u);
            asm volatile("s_waitcnt vmcnt(0)" ::: "memory");
        } else {
            XB_SPIN(xb_ld(&bar[XB_XGEN(bx)]) == gen, bar);
            __builtin_amdgcn_fence(__ATOMIC_ACQUIRE, "agent");
            asm volatile("s_waitcnt vmcnt(0)" ::: "memory");
        }
    }
    __syncthreads();
}

struct Args { const float* in[42]; float* out; unsigned char* ws; int ph_lo, ph_hi; };
enum { I_X = 0, I_MEM, I_REL, I_RW, I_RB, I_WIN, I_PEK, I_PEV, I_W1K, I_W2K, I_W1V, I_W2V, I_MU, I_W0, I_W2, I_A0, I_A2, I_G2, I_KK, I_KA, I_RK, I_GNG, I_GNB,
       I_V0, I_V1, I_V2, I_PN, I_PR, I_WOUT, I_LN1G, I_LN1B, I_XQ, I_XK, I_XV, I_XO, I_LN2G, I_LN2B, I_MG, I_MU_, I_MD, I_LN3G, I_LN3B };
template <class T> __device__ __forceinline__ T* as_global(T* p) { return (T*)(GAS T*)p; }
struct Frame {
    LAS unsigned char* lds;
    int tid, lane, wave, G, bid;
    unsigned char* ws;
};
constexpr int PT_OFF = LDSCTL_OFF + 1024;
__device__ __forceinline__ const float* inp(const Frame& F, int i) {
    const LAS unsigned* p = (const LAS unsigned*)(F.lds + PT_OFF) + 2 * i;
    const unsigned lo = __builtin_amdgcn_readfirstlane(p[0]), hi = __builtin_amdgcn_readfirstlane(p[1]);
    return (const float*)(const GAS float*)(((unsigned long long)hi << 32) | (unsigned long long)lo);
}

struct DstId { __device__ __forceinline__ int operator()(int d) const { return d; } };
struct DstWin1 { __device__ __forceinline__ int operator()(int d) const { return (d >= 3104 && d < 3168) ? -1 : d; } };
struct DstMoe { int up; __device__ __forceinline__ int operator()(int d) const { return (d >> 9) * 1024 + ((d >> 7) & 3) * 256 + (d & 127) + up; } };
template <int KPI, class SrcF, class DstF = DstId>
__device__ __forceinline__ void cvt_item(const SrcF& src, int K, bf16_t* WT, int item, int lane, const DstF dmap = DstF()) {
    const int nk = K / KPI, nb = item / nk, kb = item - nb * nk, d0 = nb * 256 + 4 * lane, k0 = KPI * kb;
#pragma unroll 2
    for (int kc = 0; kc < KPI / 8; ++kc) {
        f32x4 v[8];
#pragma unroll
        for (int e = 0; e < 8; ++e) v[e] = src(k0 + 8 * kc + e, d0);
#pragma unroll
        for (int r = 0; r < 4; ++r) { u32x4 o; o.x = pk2(v[0][r], v[1][r]); o.y = pk2(v[2][r], v[3][r]); o.z = pk2(v[4][r], v[5][r]); o.w = pk2(v[6][r], v[7][r]);
            const int dd_ = dmap(d0 + r); if (dd_ >= 0) *(u32x4*)(WT + (size_t)dd_ * K + k0 + 8 * kc) = o; }
    }
}
struct SrcPlain { const float* W; int ldw; __device__ __forceinline__ f32x4 operator()(int k, int d) const { return *(const f32x4*)(W + (size_t)k * ldw + d); } };
struct SrcWin {
    const float* W;
    __device__ __forceinline__ f32x4 operator()(int k, int d) const {
        int c;
        if (d < 1280) c = d; else if (d < 1536) c = d - 1280 + 2840; else if (d < 3072) c = d - 1536 + 1304; else if (d < 3096) c = d - 3072 + 1280; else c = -1;
        return c < 0 ? (f32x4){0.f, 0.f, 0.f, 0.f} : *(const f32x4*)(W + (size_t)k * IN_COLS + c);
    }
};
struct SrcGates { const float* W; __device__ __forceinline__ f32x4 operator()(int k, int d) const { const int p = d >> 8, i = d & 255; const int c = (i < 128) ? (3096 + 128 * p + i) : (4120 + 128 * p + (i - 128)); return *(const f32x4*)(W + (size_t)k * IN_COLS + c); } };
struct SrcMoeG { const float* W;
    __device__ __forceinline__ f32x4 operator()(int k, int d) const { return *(const f32x4*)(W + (size_t)(d >> 9) * 1024 * 512 + (size_t)k * 512 + (d & 511)); } };
struct SrcMoeD { const float* W;
    __device__ __forceinline__ f32x4 operator()(int k, int d) const { return *(const f32x4*)(W + (size_t)(d >> 10) * 512 * 1024 + (size_t)k * 1024 + (d & 1023)); } };

__device__ __forceinline__ void cvt_item_fold(const float* win1, const float* mu_v, const float* v1, bf16_t* WT, int item, int lane) {
    const int ab = lane >> 5, n = lane & 31;
#pragma unroll 1
    for (int kk = 0; kk < 4; ++kk) { const int k = 4 * item + kk; const float* wr_ = win1 + (size_t)k * IN_COLS + 2328; float acc = 0.f;
#pragma unroll 1
        for (int c0 = 0; c0 < 512; c0 += 8) { float w8[8], m8[8], v8[8];
#pragma unroll
            for (int e = 0; e < 8; ++e) { w8[e] = wr_[c0 + e]; m8[e] = mu_v[c0 + e]; v8[e] = v1[(size_t)(c0 + e) * 32 + n]; }
#pragma unroll
            for (int e = 0; e < 8; ++e) acc += w8[e] * (ab ? m8[e] : 1.f - m8[e]) * v8[e]; }
        WT[(size_t)(3104 + 32 * ab + n) * 1024 + k] = (bf16_t)f2bf(acc); }
}
template <int SET>
__device__ __forceinline__ void convert_set(const Frame& F, int wg0, int nwg) {
    bf16_t* W = (bf16_t*)(F.ws + WS_W);
    const int gw = (F.bid - wg0) * 8 + F.wave, NGW = nwg * 8, lane = F.lane;
    constexpr int KPI = (SET == 0) ? 16 : 64, MUL = 64 / KPI;
    constexpr int N_IN = 13 * 16 * MUL, N_C1 = 1 * 32 * MUL, N_XKV = 2 * 16 * MUL, N_GT = 8 * 16, N_P = 4 * 8, N_OUT = 4 * 16, N_XQ = 2 * 16, N_XO = 4 * 8, N_MG = 32 * 16, N_MD = 64 * 8, N_FOLD = 256;
    enum { K_PLAIN = 0, K_WIN, K_WIN1, K_GATES, K_MOEG, K_MOEU, K_MOED, K_FOLD };
    constexpr int PER_L = 2 * N_MG + N_MD + N_GT + 2 * N_P + N_OUT + N_XQ + N_XO, L0X = N_IN + 2 * N_C1 + 2 * N_XKV, L1X = N_FOLD + L0X;
    constexpr int MOE_L = 2 * N_MG + N_MD;
    constexpr int TOTAL = (SET == 0) ? L0X : (SET == 2) ? MOE_L : 2 * PER_L - MOE_L + L1X;
    for (int it = gw; it < TOTAL; it += NGW) {
        int r = it, kind = K_PLAIN, K = 1024, ldw = 0; const float* src = nullptr; bf16_t* dst = nullptr; bool found = false;
#define JOB(cnt, KIND, SRC, LDW, KK, DST) if (!found) { if (r < (cnt)) { kind = (KIND); src = (SRC); ldw = (LDW); K = (KK); dst = (DST); found = true; } else r -= (cnt); }
#define LAYERX(l) \
        JOB(N_IN, ((l) ? K_WIN1 : K_WIN), inp(F, I_WIN) + (size_t)(l) * 1024 * IN_COLS, 0, 1024, W + W_IN / 2 + (size_t)(l) * 3328 * 1024) \
        JOB(N_C1, K_PLAIN, inp(F, I_W1K) + (size_t)(l) * 2048 * 256, 256, 2048, W + W_C1 / 2 + (size_t)(l) * 512 * 2048) \
        JOB(N_C1, K_PLAIN, inp(F, I_W1V) + (size_t)(l) * 2048 * 256, 256, 2048, W + W_C1 / 2 + (size_t)(l) * 512 * 2048 + (size_t)256 * 2048) \
        JOB(N_XKV, K_PLAIN, inp(F, I_XK) + (size_t)(l) * 1024 * 512, 512, 1024, W + W_XKV / 2 + (size_t)(l) * 1024 * 1024) \
        JOB(N_XKV, K_PLAIN, inp(F, I_XV) + (size_t)(l) * 1024 * 512, 512, 1024, W + W_XKV / 2 + (size_t)(l) * 1024 * 1024 + (size_t)512 * 1024)
#define MOEJOBS(l) \
        JOB(N_MG, K_MOEG, inp(F, I_MG) + (size_t)(l) * 16 * 1024 * 512, 0, 1024, W + W_MGU / 2 + (size_t)(l) * 16 * 1024 * 1024) \
        JOB(N_MG, K_MOEU, inp(F, I_MU_) + (size_t)(l) * 16 * 1024 * 512, 0, 1024, W + W_MGU / 2 + (size_t)(l) * 16 * 1024 * 1024) \
        JOB(N_MD, K_MOED, inp(F, I_MD) + (size_t)(l) * 16 * 512 * 1024, 0, 512, W + W_MD / 2 + (size_t)(l) * 16 * 1024 * 512)
#define LAYERJOBS(l) \
        JOB(N_GT, K_GATES, inp(F, I_WIN) + (size_t)(l) * 1024 * IN_COLS, 0, 1024, W + W_GT / 2 + (size_t)(l) * 2048 * 1024) \
        JOB(N_P, K_PLAIN, inp(F, I_PN) + (size_t)(l) * 512 * 1024, 1024, 512, W + W_PN / 2 + (size_t)(l) * 1024 * 512) \
        JOB(N_P, K_PLAIN, inp(F, I_PR) + (size_t)(l) * 512 * 1024, 1024, 512, W + W_PR / 2 + (size_t)(l) * 1024 * 512) \
        JOB(N_OUT, K_PLAIN, inp(F, I_WOUT) + (size_t)(l) * 1024 * 1024, 1024, 1024, W + W_OUT / 2 + (size_t)(l) * 1024 * 1024) \
        JOB(N_XQ, K_PLAIN, inp(F, I_XQ) + (size_t)(l) * 1024 * 512, 512, 1024, W + W_XQ / 2 + (size_t)(l) * 512 * 1024) \
        JOB(N_XO, K_PLAIN, inp(F, I_XO) + (size_t)(l) * 512 * 1024, 1024, 512, W + W_XO / 2 + (size_t)(l) * 1024 * 512)
        if (SET == 0) { LAYERX(0) }
        else if (SET == 2) { MOEJOBS(1) }
        else { JOB(N_FOLD, K_FOLD, inp(F, I_WIN) + (size_t)1024 * IN_COLS, 0, 1024, W + W_IN / 2 + (size_t)3328 * 1024) MOEJOBS(0) LAYERJOBS(0) LAYERJOBS(1) LAYERX(1) }
#undef JOB
#undef LAYERX
#undef LAYERJOBS
#undef MOEJOBS
        switch (kind) {
            case K_PLAIN: cvt_item<KPI>(SrcPlain{src, ldw}, K, dst, r, lane); break;
            case K_WIN:   cvt_item<KPI>(SrcWin{src}, K, dst, r, lane); break;
            case K_WIN1:  cvt_item<KPI>(SrcWin{src}, K, dst, r, lane, DstWin1{}); break;
            case K_GATES: cvt_item<KPI>(SrcGates{src}, K, dst, r, lane); break;
            case K_MOEG:  cvt_item<KPI>(SrcMoeG{src}, K, dst, r, lane, DstMoe{0}); break;
            case K_MOEU:  cvt_item<KPI>(SrcMoeG{src}, K, dst, r, lane, DstMoe{128}); break;
            case K_MOED:  cvt_item<KPI>(SrcMoeD{src}, K, dst, r, lane); break;
            default:      cvt_item_fold(src, inp(F, I_MU) + 1792 + 1024, inp(F, I_V1), dst, r, lane); break;
        }
    }
}
#define GACC(n) do { if (PROBE2_A >= 40 && F.bid == PROBE_WG && F.tid == 0) { const unsigned long long t_ = __builtin_amdgcn_s_memrealtime(); volatile LAS unsigned long long* pm_ = (volatile LAS unsigned long long*)(F.lds + LDSCTL_OFF + 512); \
    if ((n) == PROBE2_A) pm_[0] = t_; if ((n) == PROBE2_B) pm_[1] += t_ - pm_[0]; } } while (0)
__device__ __forceinline__ void prologue(const Frame& F, const Args& a) {
    bf16_t* W = (bf16_t*)(F.ws + WS_W);
    GACC(40);
    convert_set<0>(F, 0, F.G);
    GACC(41);
    const int gt = F.bid * 512 + F.tid, NGT = F.G * 512;
    for (int i = gt; i < 2 * 2 * 256 * 256; i += NGT) { const int k = i & 255, n = (i >> 8) & 255, wh = (i >> 16) & 1, l = i >> 17;
        const float* w2 = inp(F, wh ? I_W2V : I_W2K) + (size_t)l * 256 * 64; W[W_C2 / 2 + i] = (bf16_t)((n < 64) ? f2bf(w2[k * 64 + n]) : 0u); }
    GACC(42);
    { const f32x4* x4 = (const f32x4*)inp(F, I_X); u32x2* xb = (u32x2*)(F.ws + WS_XB);
      for (int i0 = gt; i0 < NTOK * DM / 4; i0 += 8 * NGT) {
          f32x4 v[8];
#pragma unroll
          for (int u = 0; u < 8; ++u) { const int i = i0 + u * NGT; v[u] = x4[i < NTOK * DM / 4 ? i : i0]; }
#pragma unroll
          for (int u = 0; u < 8; ++u) { const int i = i0 + u * NGT; u32x2 o; o.x = pk2(v[u][0], v[u][1]); o.y = pk2(v[u][2], v[u][3]); if (i < NTOK * DM / 4) xb[i] = o; } }
      const f32x4* m4 = (const f32x4*)inp(F, I_MEM); u32x2* mb = (u32x2*)(W + W_MEM / 2);
      for (int i = gt; i < 1024 * 1024 / 4; i += NGT) { const f32x4 v = m4[i]; u32x2 o; o.x = pk2(v[0], v[1]); o.y = pk2(v[2], v[3]); mb[i] = o; } }
    GACC(43);
    if (gt < 1024) { const int n = gt; int bk;
        if (n < 16) bk = n; else { const double lr = log((double)n / 16.0) / log(64.0); int v = 16 + (int)(lr * 16.0); bk = v < 31 ? v : 31; }
        ((unsigned char*)(F.ws + WS_TAB + TB_BK))[n] = (unsigned char)bk; }
    if (F.bid >= F.G - 88 && F.bid < F.G - 24) {
        const int quad = (F.bid - (F.G - 88)) * 4 + (F.wave >> 1), kh = F.wave & 1, o4 = quad * 4, n = o4 & 255, wh = (o4 >> 8) & 1, l = o4 >> 9;
        const float* pe = inp(F, wh ? I_PEV : I_PEK) + (size_t)l * 2048 + kh * 1024; const float* w1 = inp(F, wh ? I_W1V : I_W1K) + (size_t)l * 2048 * 256 + (size_t)kh * 1024 * 256;
        const int sub = F.lane & 3, kq = F.lane >> 2;
        float sacc = 0.f;
#pragma unroll 1
        for (int i0 = 0; i0 < 64; i0 += 16) { float pv[16], wv[16];
#pragma unroll
            for (int u = 0; u < 16; ++u) { const int k = kq + 16 * (i0 + u); pv[u] = pe[k]; wv[u] = w1[(size_t)k * 256 + n + sub]; }
#pragma unroll
            for (int u = 0; u < 16; ++u) sacc += pv[u] * wv[u]; }
#pragma unroll
        for (int o = 4; o < 64; o <<= 1) sacc += __shfl_xor(sacc, o);
        LAS float* part = (LAS float*)F.lds;
        if (kh == 1 && F.lane < 4) part[(F.wave >> 1) * 4 + sub] = sacc;
        __syncthreads();
        if (kh == 0 && F.lane < 4) ((float*)(F.ws + WS_TAB + TB_CB))[o4 + sub] = sacc + part[(F.wave >> 1) * 4 + sub];
    }
    GACC(44);
}
struct RowV { f32x4 v[4]; };
__device__ __forceinline__ void ln_apply_store(RowV& r, const RowV& g, const RowV& b, float* orow, bf16_t* xbrow, int lane, bool wr_x = true, bool wr_xb = true) {
    float s = 0.f;
#pragma unroll
    for (int j = 0; j < 4; ++j) s += (r.v[j][0] + r.v[j][1]) + (r.v[j][2] + r.v[j][3]);
    const float mean = wave_sum(s) * (1.f / DM); float s2 = 0.f;
#pragma unroll
    for (int j = 0; j < 4; ++j) { r.v[j] = r.v[j] - mean; s2 += (r.v[j][0] * r.v[j][0] + r.v[j][1] * r.v[j][1]) + (r.v[j][2] * r.v[j][2] + r.v[j][3] * r.v[j][3]); }
    const float rstd = rsqf(wave_sum(s2) * (1.f / DM) + LN_EPS);
#pragma unroll
    for (int j = 0; j < 4; ++j) { r.v[j] = r.v[j] * rstd * g.v[j] + b.v[j];
        if (wr_x) *((f32x4*)orow + lane + 64 * j) = r.v[j];
        if (wr_xb) { u32x2 o; o.x = pk2(r.v[j][0], r.v[j][1]); o.y = pk2(r.v[j][2], r.v[j][3]); *((u32x2*)xbrow + lane + 64 * j) = o; } }
}
__device__ __forceinline__ void load_gb(const float* g, const float* b, RowV& G, RowV& B, int lane) {
#pragma unroll
    for (int j = 0; j < 4; ++j) { G.v[j] = *((const f32x4*)g + lane + 64 * j); B.v[j] = *((const f32x4*)b + lane + 64 * j); }
}
__device__ __forceinline__ void load_row_bf16(const bf16_t* yr, RowV& r, int lane) {
#pragma unroll
    for (int j = 0; j < 4; ++j) { const u32x2 w = *((const u32x2*)yr + lane + 64 * j); r.v[j][0] = bflo(w.x); r.v[j][1] = bfhi(w.x); r.v[j][2] = bflo(w.y); r.v[j][3] = bfhi(w.y); }
}
__device__ __forceinline__ void ln_phase(const Frame& F, const bf16_t* y, const float* g, const float* b, bool dry = false) {
    RowV Gv, Bv; load_gb(g, b, Gv, Bv, F.lane);
    bf16_t* xb = (bf16_t*)(F.ws + WS_XB);
    const int stride = F.G * 8;
    for (int row0 = F.bid * 8 + F.wave; row0 < NTOK; row0 += 4 * stride) {
        RowV r[4];
#pragma unroll
        for (int k = 0; k < 4; ++k) { const int row = row0 + k * stride; load_row_bf16(y + (size_t)(row < NTOK ? row : row0) * DM, r[k], F.lane); }
#pragma unroll
        for (int k = 0; k < 4; ++k) { const int row = row0 + k * stride; if (row < NTOK) ln_apply_store(r[k], Gv, Bv, nullptr, xb + (size_t)row * DM, F.lane, false, !dry); }
    }
}
__device__ __forceinline__ void ln2_route_phase(const Frame& F, const Args& a, int l, const bf16_t* y, bool dry = false) {
    LAS float* RW = (LAS float*)F.lds;
    { const float* rw = inp(F, I_RW); for (int i = F.tid; i < 1024 * 16; i += 512) { const int c = i >> 4, e = i & 15; RW[e * 1024 + c] = rw[i]; } }
    __syncthreads();
    RowV Gv, Bv; load_gb(inp(F, I_LN2G) + (size_t)l * DM, inp(F, I_LN2B) + (size_t)l * DM, Gv, Bv, F.lane);
    bf16_t* xb = (bf16_t*)(F.ws + WS_XB);
    float rb[16];
#pragma unroll
    for (int e = 0; e < 16; ++e) rb[e] = inp(F, I_RB)[e];
    unsigned* cnt = (unsigned*)(F.ws + WS_CTL) + CW_CNT + l * 64;
    int* list = (int*)(F.ws + WS_TAB + TB_LIST); float* gate = (float*)(F.ws + WS_TAB + TB_GATE); int* pos = (int*)(F.ws + WS_TAB + TB_POS);
    LAS unsigned* lcnt = (LAS unsigned*)(F.lds + 65536 + 1024);
    LAS unsigned* rec = (LAS unsigned*)(F.lds + 65536 + 2048) + F.wave * (4 * 64);
    if (F.tid < 32) lcnt[F.tid] = 0u;
    __syncthreads();
    int nrec = 0;
    u32x2 nx[4];
    { const int row = F.bid * 8 + F.wave;
#pragma unroll
      for (int j = 0; j < 4; ++j) nx[j] = *((const u32x2*)(y + (size_t)(row < NTOK ? row : 0) * DM) + F.lane + 64 * j); }
    for (int row = F.bid * 8 + F.wave; row < NTOK; row += F.G * 8) {
        RowV r;
#pragma unroll
        for (int j = 0; j < 4; ++j) { r.v[j][0] = bflo(nx[j].x); r.v[j][1] = bfhi(nx[j].x); r.v[j][2] = bflo(nx[j].y); r.v[j][3] = bfhi(nx[j].y); }
        { const int rn = row + F.G * 8 < NTOK ? row + F.G * 8 : row;
#pragma unroll
          for (int j = 0; j < 4; ++j) nx[j] = *((const u32x2*)(y + (size_t)rn * DM) + F.lane + 64 * j); }
        ln_apply_store(r, Gv, Bv, nullptr, xb + (size_t)row * DM, F.lane, false, !dry);
        LAS float* lgt = (LAS float*)(F.lds + 65536) + F.wave * 16;
        float pa[16];
#pragma unroll
        for (int e = 0; e < 16; ++e) { float p = 0.f;
#pragma unroll
            for (int j = 0; j < 4; ++j) { const f32x4 w = *((const LAS f32x4*)(RW + e * 1024) + F.lane + 64 * j); p += (r.v[j][0] * w[0] + r.v[j][1] * w[1]) + (r.v[j][2] * w[2] + r.v[j][3] * w[3]); }
            pa[e] = p; if ((e & 3) == 3) asm volatile("" ::: "memory"); }
        { float v8[8], v4[4], v2[2];
          { const bool bt = (F.lane & 32) != 0;
#pragma unroll
            for (int i = 0; i < 8; ++i) { const float ka = bt ? pa[8 + i] : pa[i], sb = bt ? pa[i] : pa[8 + i]; v8[i] = ka + __shfl_xor(sb, 32); } }
          { const bool bt = (F.lane & 16) != 0;
#pragma unroll
            for (int i = 0; i < 4; ++i) { const float ka = bt ? v8[4 + i] : v8[i], sb = bt ? v8[i] : v8[4 + i]; v4[i] = ka + __shfl_xor(sb, 16); } }
          { const bool bt = (F.lane & 8) != 0;
#pragma unroll
            for (int i = 0; i < 2; ++i) { const float ka = bt ? v4[2 + i] : v4[i], sb = bt ? v4[i] : v4[2 + i]; v2[i] = ka + __shfl_xor(sb, 8); } }
          float v1; { const bool bt = (F.lane & 4) != 0; const float ka = bt ? v2[1] : v2[0], sb = bt ? v2[0] : v2[1]; v1 = ka + __shfl_xor(sb, 4); }
          v1 += __shfl_xor(v1, 2); v1 += __shfl_xor(v1, 1);
          const int eidx = (((F.lane >> 5) & 1) << 3) | (((F.lane >> 4) & 1) << 2) | (((F.lane >> 3) & 1) << 1) | ((F.lane >> 2) & 1);
          if ((F.lane & 3) == 0) lgt[eidx] = v1; }
        LDS_WAIT(); asm volatile("" ::: "memory");
        float s[16], ss[16];
#pragma unroll
        for (int e = 0; e < 16; ++e) { const float p = lgt[e]; s[e] = sigmoidf_(p); ss[e] = s[e] + rb[e]; }
        int bestg = 0; float bestv = -1e30f;
#pragma unroll
        for (int gi = 0; gi < 4; ++gi) { const float a0 = ss[4 * gi], a1 = ss[4 * gi + 1], a2 = ss[4 * gi + 2], a3 = ss[4 * gi + 3];
            const float hi = fmaxf(a0, a1), lo = fminf(a0, a1), hi2 = fmaxf(a2, a3), lo2 = fminf(a2, a3);
            const float gs = fmaxf(hi, hi2) + fmaxf(fminf(hi, hi2), fmaxf(lo, lo2));
            if (gs > bestv) { bestv = gs; bestg = gi; } }
        int e1 = 0; float v1 = -1e30f, s1 = 0.f;
#pragma unroll
        for (int e = 0; e < 16; ++e) { const bool ing = (e >> 2) == bestg; if (ing && ss[e] > v1) { v1 = ss[e]; e1 = e; s1 = s[e]; } }
        int e2 = 0; float v2 = -1e30f, s2v = 0.f;
#pragma unroll
        for (int e = 0; e < 16; ++e) { const bool ing = ((e >> 2) == bestg) && (e != e1); if (ing && ss[e] > v2) { v2 = ss[e]; e2 = e; s2v = s[e]; } }
        if (F.lane == 0 && !dry) { const float inv = 1.f / (s1 + s2v);
            const unsigned l1 = __hip_atomic_fetch_add(lcnt + e1, 1u, __ATOMIC_RELAXED, __HIP_MEMORY_SCOPE_WORKGROUP), l2 = __hip_atomic_fetch_add(lcnt + e2, 1u, __ATOMIC_RELAXED, __HIP_MEMORY_SCOPE_WORKGROUP);
            rec[nrec * 4 + 0] = (unsigned)row; rec[nrec * 4 + 1] = (unsigned)e1 | ((unsigned)e2 << 8); rec[nrec * 4 + 2] = l1; rec[nrec * 4 + 3] = l2;
            gate[row * 2] = s1 * inv; gate[row * 2 + 1] = s2v * inv; }
        ++nrec;
    }
    __syncthreads();
    if (F.tid < 16 && !dry) lcnt[16 + F.tid] = __hip_atomic_fetch_add(cnt + F.tid, lcnt[F.tid], RLX_AGENT);
    __syncthreads();
    if (F.lane == 0 && !dry) for (int i = 0; i < nrec; ++i) { const unsigned row = rec[i * 4], ee = rec[i * 4 + 1], e1 = ee & 255u, e2 = ee >> 8;
        const unsigned s1_ = lcnt[16 + e1] + rec[i * 4 + 2], s2_ = lcnt[16 + e2] + rec[i * 4 + 3];
        list[(size_t)e1 * NTOK + s1_] = (int)(row * 2u); list[(size_t)e2 * NTOK + s2_] = (int)(row * 2u + 1u);
        pos[row * 2u] = (int)((e1 << 24) | s1_); pos[row * 2u + 1u] = (int)((e2 << 24) | s2_); }
}
__device__ __forceinline__ void moe_tables(const Frame& F, int l, LAS int* PE) {
    if (F.tid == 0) { const unsigned* cnt = (const unsigned*)(F.ws + WS_CTL) + CW_CNT + l * 64; int acc = 0;
        for (int e = 0; e < 16; ++e) { const int c = (int)__hip_atomic_load(cnt + e, RLX_AGENT); PE[32 + e] = acc * 256; acc += (c + 255) >> 8; PE[e] = acc; PE[16 + e] = c; } }
    __syncthreads();
}
__device__ __forceinline__ void moe_gather_phase(const Frame& F, int l) {
    LAS int* PE = (LAS int*)F.lds; moe_tables(F, l, PE);
    const int total = PE[15] * 256;
    const int* list = (const int*)(F.ws + WS_TAB + TB_LIST); int* pos = (int*)(F.ws + WS_TAB + TB_POS);
    const bf16_t* xb = (const bf16_t*)(F.ws + WS_XB); bf16_t* xs = (bf16_t*)(F.ws + WS_Z + Z_XS);
    for (int R = F.bid * 8 + F.wave; R < total; R += F.G * 8) {
        const int gt = R >> 8; int e = 0;
#pragma unroll
        for (int k = 0; k < 15; ++k) e += (gt >= PE[k]) ? 1 : 0;
        const int s = R - PE[32 + e]; u32x4 v0 = (u32x4){0u, 0u, 0u, 0u}, v1 = v0;
        if (s < PE[16 + e]) { const int entry = list[(size_t)e * NTOK + s]; const u32x4* src = (const u32x4*)(xb + (size_t)(entry >> 1) * DM); v0 = src[F.lane]; v1 = src[F.lane + 64]; if (F.lane == 0) pos[entry] = R; }
        u32x4* dst = (u32x4*)(xs + (size_t)R * DM); dst[F.lane] = v0; dst[F.lane + 64] = v1;
    }
}
__device__ __forceinline__ void ln3_phase(const Frame& F, const Args& a, int l, float* x, bool wr_x, bool wr_xb) {
    RowV Gv, Bv; load_gb(inp(F, I_LN3G) + (size_t)l * DM, inp(F, I_LN3B) + (size_t)l * DM, Gv, Bv, F.lane);
    bf16_t* xb = (bf16_t*)(F.ws + WS_XB); const bf16_t* ys = (const bf16_t*)(F.ws + WS_Z + Z_XS);
    const int* pos = (const int*)(F.ws + WS_TAB + TB_POS); const float* gate = (const float*)(F.ws + WS_TAB + TB_GATE);
    LAS int* PEl = (LAS int*)F.lds; moe_tables(F, l, PEl);
    const int stride = F.G * 8;
    for (int row0 = F.bid * 8 + F.wave; row0 < NTOK; row0 += 2 * stride) {
        RowV r[2]; u32x2 xv[2][4]; u32x2 u0[2][4], u1[2][4]; float g0[2], g1[2]; int rows[2] = {row0, row0 + stride};
#pragma unroll
        for (int k = 0; k < 2; ++k) { const int row = rows[k] < NTOK ? rows[k] : row0;
            const int q0 = pos[row * 2], q1 = pos[row * 2 + 1]; const int p0 = PEl[32 + (q0 >> 24)] + (q0 & 0xffffff), p1 = PEl[32 + (q1 >> 24)] + (q1 & 0xffffff); g0[k] = gate[row * 2]; g1[k] = gate[row * 2 + 1];
            const u32x2* y0 = (const u32x2*)(ys + (size_t)p0 * DM); const u32x2* y1 = (const u32x2*)(ys + (size_t)p1 * DM); const u32x2* xr = (const u32x2*)(xb + (size_t)row * DM);
#pragma unroll
            for (int j = 0; j < 4; ++j) { xv[k][j] = xr[F.lane + 64 * j]; u0[k][j] = y0[F.lane + 64 * j]; u1[k][j] = y1[F.lane + 64 * j]; } }
#pragma unroll
        for (int k = 0; k < 2; ++k) { if (rows[k] >= NTOK) continue;
#pragma unroll
            for (int j = 0; j < 4; ++j) { f32x4 t; t[0] = bflo(u0[k][j].x) * g0[k] + bflo(u1[k][j].x) * g1[k]; t[1] = bfhi(u0[k][j].x) * g0[k] + bfhi(u1[k][j].x) * g1[k];
                t[2] = bflo(u0[k][j].y) * g0[k] + bflo(u1[k][j].y) * g1[k]; t[3] = bfhi(u0[k][j].y) * g0[k] + bfhi(u1[k][j].y) * g1[k]; f32x4 xf; xf[0] = bflo(xv[k][j].x); xf[1] = bfhi(xv[k][j].x); xf[2] = bflo(xv[k][j].y); xf[3] = bfhi(xv[k][j].y); r[k].v[j] = xf * DN_ALPHA + t; }
            ln_apply_store(r[k], Gv, Bv, x + (size_t)rows[k] * DM, xb + (size_t)rows[k] * DM, F.lane, wr_x, wr_xb); }
    }
}
namespace att {
template <int HD> struct St { float m, l; f32x4 o[HD / 16]; };
template <int HD> struct KV { bf16x8 k[2][HD / 32]; bf16x8 v[HD / 16]; };
template <int HD> __device__ __forceinline__ void init(St<HD>& st) { st.m = MINIT; st.l = 0.f;
#pragma unroll
    for (int i = 0; i < HD / 16; ++i) st.o[i] = (f32x4){0.f, 0.f, 0.f, 0.f}; }
template <int HD> __device__ __forceinline__ void load_k(KV<HD>& kv, const bf16_t* Kp, int kpitch, int fr, int fq) {
#pragma unroll
    for (int tau = 0; tau < 2; ++tau) { const int row = 8 * (fr >> 2) + 4 * tau + (fr & 3);
#pragma unroll
        for (int ks = 0; ks < HD / 32; ++ks) kv.k[tau][ks] = *(const bf16x8*)(Kp + (size_t)row * kpitch + 32 * ks + 8 * fq); }
}
template <int HD> __device__ __forceinline__ void load_v(KV<HD>& kv, const bf16_t* Vt, int vpitch, int fr, int fq) {
#pragma unroll
    for (int mt = 0; mt < HD / 16; ++mt) kv.v[mt] = *(const bf16x8*)(Vt + (size_t)(16 * mt + fr) * vpitch + 8 * fq);
}
template <int HD> __device__ __forceinline__ void qk(f32x4 (&s)[2], const bf16x8 (&qf)[HD / 32], const KV<HD>& kv, float cinit = 0.f) {
#pragma unroll
    for (int tau = 0; tau < 2; ++tau) { s[tau] = (f32x4){cinit, cinit, cinit, cinit};
#pragma unroll
        for (int ks = 0; ks < HD / 32; ++ks) s[tau] = __builtin_amdgcn_mfma_f32_16x16x32_bf16(kv.k[tau][ks], qf[ks], s[tau], 0, 0, 0); }
}
template <int HD> __device__ __forceinline__ void softmax_pv(St<HD>& st, f32x4 (&s)[2], const KV<HD>& kv) {
    float mx = fmaxf(fmaxf(fmaxf(s[0][0], s[0][1]), fmaxf(s[0][2], s[0][3])), fmaxf(fmaxf(s[1][0], s[1][1]), fmaxf(s[1][2], s[1][3])));
    if (__any(mx > st.m + 8.f)) {
        mx = fmaxf(mx, __shfl_xor(mx, 16)); mx = fmaxf(mx, __shfl_xor(mx, 32));
        const float mn = fmaxf(st.m, mx), alpha = ex2(st.m - mn); st.m = mn; st.l *= alpha;
#pragma unroll
        for (int mt = 0; mt < HD / 16; ++mt) st.o[mt] *= alpha;
    }
    float sum = 0.f; const float mref = st.m;
#pragma unroll
    for (int tau = 0; tau < 2; ++tau)
#pragma unroll
        for (int i = 0; i < 4; ++i) { s[tau][i] = ex2(s[tau][i] - mref); sum += s[tau][i]; }
    st.l += sum;
    const u32x4 pw = pg8::pack8(s[0], s[1]); const bf16x8 pB = __builtin_bit_cast(bf16x8, pw);
#pragma unroll
    for (int mt = 0; mt < HD / 16; ++mt) st.o[mt] = __builtin_amdgcn_mfma_f32_16x16x32_bf16(kv.v[mt], pB, st.o[mt], 0, 0, 0);
}
template <int HD> __device__ __forceinline__ float finish(St<HD>& st) { float lt = st.l; lt += __shfl_xor(lt, 16); lt += __shfl_xor(lt, 32); return lt > 0.f ? 1.f / lt : 0.f; }
}

constexpr int NSA_BT_BYTES = 32768 + 1024, NSA_WAVE_BYTES = 2560, NSA_BUF_OFF = NSA_BT_BYTES + 8 * NSA_WAVE_BYTES, NSA_IMG = 8192, NSA_BUF_BYTES = 2 * NSA_IMG, NSA_DEPTH = 4;
static_assert(NSA_BUF_OFF + NSA_DEPTH * NSA_BUF_BYTES <= RING_BYTES, "nsa lds");
#define NSA_BT_BASE(h) ((h) * 1056 + (((h) & 1) << 2) + (((h) & 2) << 3))
__device__ __forceinline__ void nsa_build_bias(const Frame& F, const Args& a) {
    LAS float* BT = (LAS float*)F.lds; const unsigned char* bk = (const unsigned char*)(F.ws + WS_TAB + TB_BK); const float* rel = inp(F, I_REL);
    for (int i = F.tid; i < 8 * 1024; i += 512) { const int h = i >> 10, d = i & 1023; BT[NSA_BT_BASE(h) + d] = rel[bk[d] * 8 + h] * LOG2E; }
    __syncthreads();
}
#define NSA_LBAR() asm volatile("s_waitcnt lgkmcnt(0)\n\ts_barrier" ::: "memory")
__device__ __forceinline__ void nsa_load_k(bf16x8 (&kA)[4][2], const LAS unsigned char* img, int fr, int fq) {
#pragma unroll
    for (int t = 0; t < 4; ++t) { const int row = 32 * (t >> 1) + 8 * (fr >> 2) + 4 * (t & 1) + (fr & 3);
#pragma unroll
        for (int ks = 0; ks < 2; ++ks) kA[t][ks] = *(const LAS bf16x8*)(img + row * 128 + (((4 * ks + fq) ^ ((((row >> 3) & 3) << 1) | ((row >> 1) & 1))) << 4)); }
}
__device__ __forceinline__ void nsa_qk_block(f32x4 (&s)[4], const bf16x8 (&qf)[2], const bf16x8 (&kA)[4][2], float cinit) {
#pragma unroll
    for (int t = 0; t < 4; ++t) { s[t] = (f32x4){cinit, cinit, cinit, cinit};
#pragma unroll
        for (int ks = 0; ks < 2; ++ks) s[t] = __builtin_amdgcn_mfma_f32_16x16x32_bf16(kA[t][ks], qf[ks], s[t], 0, 0, 0); }
}
__device__ __forceinline__ float nsa_shift(const att::St<64>& st) { return st.m > -20000.f ? st.m : 0.f; }
__device__ __forceinline__ void nsa_softmax_pv_block(att::St<64>& st, f32x4 (&s)[4], const LAS unsigned char* img, int fr, int fq, const float sh) {
    int mi;
    { typedef int i32x4_ __attribute__((ext_vector_type(4)));
      const i32x4_ b0 = __builtin_bit_cast(i32x4_, s[0]), b1 = __builtin_bit_cast(i32x4_, s[1]), b2 = __builtin_bit_cast(i32x4_, s[2]), b3 = __builtin_bit_cast(i32x4_, s[3]);
      const int a0 = max(max(b0[0], b0[1]), max(b0[2], b0[3])), a1 = max(max(b1[0], b1[1]), max(b1[2], b1[3])), a2 = max(max(b2[0], b2[1]), max(b2[2], b2[3])), a3 = max(max(b3[0], b3[1]), max(b3[2], b3[3]));
      mi = max(max(a0, a1), max(a2, a3)); }
    if (__any((mi > 0x41000000) | (sh != st.m))) {
        float mx = fmaxf(fmaxf(fmaxf(s[0][0], s[0][1]), fmaxf(s[0][2], s[0][3])), fmaxf(fmaxf(s[1][0], s[1][1]), fmaxf(s[1][2], s[1][3])));
        mx = fmaxf(mx, fmaxf(fmaxf(fmaxf(s[2][0], s[2][1]), fmaxf(s[2][2], s[2][3])), fmaxf(fmaxf(s[3][0], s[3][1]), fmaxf(s[3][2], s[3][3]))));
        mx += sh;
        mx = fmaxf(mx, __shfl_xor(mx, 16)); mx = fmaxf(mx, __shfl_xor(mx, 32));
        const float mn = fmaxf(st.m, mx), alpha = ex2(st.m - mn); st.m = mn; st.l *= alpha;
#pragma unroll
        for (int mt = 0; mt < 4; ++mt) st.o[mt] *= alpha;
        const float d = sh - mn;
#pragma unroll
        for (int t = 0; t < 4; ++t) s[t] += d;
    }
    bf16x8 vA0[4];
#pragma unroll
    for (int mt = 0; mt < 4; ++mt) { const int row = 16 * mt + fr; vA0[mt] = *(const LAS bf16x8*)(img + NSA_IMG + row * 128 + ((fq ^ (row & 7)) << 4)); }
    float sum = 0.f;
#pragma unroll
    for (int t = 0; t < 4; ++t)
#pragma unroll
        for (int i = 0; i < 4; ++i) { s[t][i] = ex2(s[t][i]); sum += s[t][i]; }
    st.l += sum;
    bf16x8 pB[2];
#pragma unroll
    for (int kp = 0; kp < 2; ++kp) { const u32x4 pw = pg8::pack8(s[2 * kp], s[2 * kp + 1]); pB[kp] = __builtin_bit_cast(bf16x8, pw); }
    bf16x8 vA1[4];
#pragma unroll
    for (int mt = 0; mt < 4; ++mt) { const int row = 16 * mt + fr; vA1[mt] = *(const LAS bf16x8*)(img + NSA_IMG + row * 128 + (((4 + fq) ^ (row & 7)) << 4)); }
#pragma unroll
    for (int mt = 0; mt < 4; ++mt) st.o[mt] = __builtin_amdgcn_mfma_f32_16x16x32_bf16(vA0[mt], pB[0], st.o[mt], 0, 0, 0);
#pragma unroll
    for (int mt = 0; mt < 4; ++mt) st.o[mt] = __builtin_amdgcn_mfma_f32_16x16x32_bf16(vA1[mt], pB[1], st.o[mt], 0, 0, 0);
}
#define NACC(n) do { if (PROBE2_A >= 20 && F.bid == PROBE_WG && F.tid == 0) { const unsigned long long t_ = __builtin_amdgcn_s_memrealtime(); volatile LAS unsigned long long* pm_ = (volatile LAS unsigned long long*)(F.lds + LDSCTL_OFF + 512); \
    if ((n) == PROBE2_A) pm_[0] = t_; if ((n) == PROBE2_B) pm_[1] += t_ - pm_[0]; } } while (0)
__device__ __forceinline__ void nsa_item(const Frame& F, int b, int g, int t0, bf16_t* obase) {
    NACC(20);
    const int lane = F.lane, fr = lane & 15, fq = lane >> 4, q = fr >> 2, hg = fr & 3, tid = F.tid;
    const int tq0 = t0 + 4 * F.wave, tq = tq0 + q, head = g * 4 + hg, tok = b * SEQ + tq, jq = t0 >> 6, slab = b * 2 + g;
    const LAS float* BTh = (const LAS float*)F.lds + NSA_BT_BASE(head);
    LAS float* impL = (LAS float*)(F.lds + NSA_BT_BYTES + F.wave * NSA_WAVE_BYTES); LAS unsigned* selW = (LAS unsigned*)(impL + 512); LAS unsigned char* selB = (LAS unsigned char*)selW;
    LAS unsigned char* BUF = F.lds + NSA_BUF_OFF;
    bf16_t* qb = (bf16_t*)(F.ws + WS_Z + Z_QB); const bf16_t* kv6 = (const bf16_t*)(F.ws + WS_Z + Z_KV6);
    const bf16_t* KC = (const bf16_t*)(F.ws + WS_Z + Z_KCMP) + (size_t)slab * 512 * 64; const bf16_t* VCT = (const bf16_t*)(F.ws + WS_Z + Z_VCMPT) + (size_t)slab * 64 * 512;
    const size_t SLAB = (size_t)8192 * 64;
    const bf16_t* KS = kv6 + (size_t)(2 * 8 + slab) * SLAB; const bf16_t* VST = kv6 + (size_t)(3 * 8 + slab) * SLAB;
    const bf16_t* KW = kv6 + (size_t)(4 * 8 + slab) * SLAB; const bf16_t* VWT = kv6 + (size_t)(5 * 8 + slab) * SLAB;
    bf16x8 qf[2];
#pragma unroll
    for (int ks = 0; ks < 2; ++ks) qf[ks] = *(const bf16x8*)(qb + (size_t)tok * 512 + head * 64 + 32 * ks + 8 * fq);
    const float* gp = (const float*)(F.ws + WS_Z + Z_GN) + (size_t)tok * 32 + head * 3; const float gc = gp[0], gs = gp[1], gw = gp[2];
    f32x4 otot[4];
    att::St<64> st; f32x4 s[4]; const float b31 = BTh[1023];
    const int srow = 8 * F.wave + (lane >> 3), scol = (((lane & 7) ^ (lane >> 3)) & 7) * 8;
    const int scolK = (((lane & 7) ^ (((F.wave & 3) << 1) | ((lane >> 4) & 1))) & 7) * 8;
    const __amdgpu_buffer_rsrc_t rsrc = __builtin_amdgcn_make_buffer_rsrc((void*)F.ws, 0, 0x7ffffff0, 0x00020000);
    const unsigned sdstw = NSA_BUF_OFF + F.wave * 1024;
#define BIASIDX(d_) ((d_) < 0 ? 0 : ((d_) > 1023 ? 1023 : (d_)))
#define NSA_DMA(slot, KP, VP, HASV) do { \
        __builtin_amdgcn_raw_ptr_buffer_load_lds(rsrc, (LAS void*)(F.lds + sdstw + (slot) * NSA_BUF_BYTES), 16, (int)(unsigned)((const unsigned char*)(KP) - F.ws), 0, 0, 0); \
        if (HASV) __builtin_amdgcn_raw_ptr_buffer_load_lds(rsrc, (LAS void*)(F.lds + sdstw + (slot) * NSA_BUF_BYTES + NSA_IMG), 16, (int)(unsigned)((const unsigned char*)(VP) - F.ws), 0, 0, 0); } while (0)
#define NSA_PASS(FIRST, NEXT, KPTR, VPTR, HASV, ACT, STEP) do { \
        int cur_ = (FIRST); \
        if (cur_ >= 0) { \
            int pf_ = cur_;                                          \
            NSA_DMA(0, KPTR(pf_), VPTR(pf_), HASV); \
            { const int n_ = NEXT(pf_); pf_ = n_ >= 0 ? n_ : pf_; } NSA_DMA(1, KPTR(pf_), VPTR(pf_), HASV); \
            { const int n_ = NEXT(pf_); pf_ = n_ >= 0 ? n_ : pf_; } NSA_DMA(2, KPTR(pf_), VPTR(pf_), HASV); \
            int slot_ = 0; \
            for (;;) { \
                if (HASV) asm volatile("s_waitcnt vmcnt(4)" ::: "memory"); else asm volatile("s_waitcnt vmcnt(2)" ::: "memory"); \
                NSA_LBAR(); \
                const bool act_ = ACT(cur_); const LAS unsigned char* img_ = F.lds + NSA_BUF_OFF + slot_ * NSA_BUF_BYTES; bf16x8 kA_[4][2]; \
                if (act_) nsa_load_k(kA_, img_, fr, fq);                       \
                if (act_) { STEP(cur_, img_); } \
                { const int n_ = NEXT(pf_); pf_ = n_ >= 0 ? n_ : pf_; } NSA_DMA((slot_ + 3) & 3, KPTR(pf_), VPTR(pf_), HASV);        \
                const int nxt_ = NEXT(cur_); \
                if (nxt_ < 0) break; \
                cur_ = nxt_; slot_ = (slot_ + 1) & 3; \
            } \
            asm volatile("s_waitcnt vmcnt(0)" ::: "memory"); NSA_LBAR(); \
        } } while (0)
    const int nmax = (tq0 + 3 - 31) >> 4, nsteps = (tq0 + 3 < 31) ? 0 : (nmax >> 5) + 1;
    const int nmaxW = (t0 + 31 - 31) >> 4, nblkC = (t0 + 31 < 31) ? 0 : (((nmaxW >> 5) + 1) + 1) >> 1;
#define C_NEXT(j) (((j) + 1 < nblkC) ? (j) + 1 : -1)
#define C_KPTR(j) (KC + ((size_t)(64 * (j) + srow)) * 64 + scolK)
#define C_VPTR(j) (VCT + (size_t)srow * 512 + 64 * (j) + scol)
#define C_ACT(j) (2 * (j) < nsteps)
#define ELEM_LOOP _Pragma("unroll") for (int t = 0; t < 4; ++t) _Pragma("unroll") for (int i = 0; i < 4; ++i)
#define KOFF (32 * (t >> 1) + 8 * fq + 4 * (t & 1) + i)
#define BIAS_PIN(bb) asm volatile("" : "+v"(bb[0][0]), "+v"(bb[0][1]), "+v"(bb[0][2]), "+v"(bb[0][3]), "+v"(bb[1][0]), "+v"(bb[1][1]), "+v"(bb[1][2]), "+v"(bb[1][3]), \
                                      "+v"(bb[2][0]), "+v"(bb[2][1]), "+v"(bb[2][2]), "+v"(bb[2][3]), "+v"(bb[3][0]), "+v"(bb[3][1]), "+v"(bb[3][2]), "+v"(bb[3][3]))
#define C_STEP(j, img) do { const float sh_ = nsa_shift(st); \
        if (tq0 - (16 * (64 * (j) + 63) + 31) >= 1023) { nsa_qk_block(s, qf, kA_, b31 - sh_); }         \
        else { nsa_qk_block(s, qf, kA_, -sh_); \
        float bb_[4][4]; ELEM_LOOP { const int n = 64 * (j) + KOFF, dist = tq - (16 * n + 31); bb_[t][i] = BTh[BIASIDX(dist)]; } BIAS_PIN(bb_); \
        ELEM_LOOP { const int n = 64 * (j) + KOFF, dist = tq - (16 * n + 31); s[t][i] = dist >= 0 ? s[t][i] + bb_[t][i] : NEGV; } } \
        nsa_softmax_pv_block(st, s, img, fr, fq, sh_); } while (0)
    att::init(st);
    NSA_PASS((nblkC > 0 ? 0 : -1), C_NEXT, C_KPTR, C_VPTR, true, C_ACT, C_STEP);
    const float invc = att::finish(st), mc = st.m;
#pragma unroll
    for (int mt = 0; mt < 4; ++mt) otot[mt] = st.o[mt] * (invc * gc);
    NACC(21);
    const int q2 = fq, jj = fr;
    unsigned sb = 0u;
    if (jq >= 16) {
#pragma unroll
        for (int e = 0; e < 8; ++e) impL[lane * 8 + e] = 0.f;
        float carry = 0.f;
#define I_STEP(j, img) do { nsa_qk_block(s, qf, kA_, 0.f); \
        float bb_[4][4]; ELEM_LOOP { const int n = 64 * (j) + KOFF, dist = tq - (16 * n + 31); bb_[t][i] = BTh[BIASIDX(dist)]; } BIAS_PIN(bb_); \
        _Pragma("unroll") for (int kp = 0; kp < 2; ++kp) { float pp[8]; \
        _Pragma("unroll") for (int tau = 0; tau < 2; ++tau) _Pragma("unroll") for (int i = 0; i < 4; ++i) { const int n = 64 * (j) + 32 * kp + 8 * fq + 4 * tau + i, dist = tq - (16 * n + 31); const float bias = bb_[2 * kp + tau][i]; \
            pp[4 * tau + i] = dist >= 0 ? ex2(s[2 * kp + tau][i] + bias - mc) * invc : 0.f; } \
          \
        const float rA = red4((pp[0] + pp[1]) + (pp[2] + pp[3])), rB = red4(pp[3] + ((pp[4] + pp[5]) + (pp[6] + pp[7]))), r7 = red4(pp[7]); \
        const float prev = __shfl((fq == 3) ? carry : r7, (lane + 48) & 63);      \
        carry = r7; \
        const float imp0 = prev + rA, imp1 = rB; \
        if (hg == 0) { const int j0 = 8 * (2 * (j) + kp) + 2 * fq; impL[q * 128 + j0] = imp0; impL[q * 128 + j0 + 1] = imp1; } } } while (0)
        NSA_PASS((nblkC > 0 ? 0 : -1), C_NEXT, C_KPTR, C_VPTR, false, C_ACT, I_STEP);
        LDS_WAIT();
        unsigned ck[8];
#pragma unroll
        for (int e = 0; e < 8; ++e) { const int j = 8 * jj + e; const float v = impL[q2 * 128 + j]; ck[e] = (j >= 1 && j <= jq - 2) ? ((__builtin_bit_cast(unsigned, v) & ~127u) | (unsigned)(127 - j)) : 0u; }
        for (int r = 0; r < 13; ++r) {
            unsigned m = max(max(max(ck[0], ck[1]), max(ck[2], ck[3])), max(max(ck[4], ck[5]), max(ck[6], ck[7])));
#define AMX_STEP(CTRL) m = max(m, (unsigned)__builtin_amdgcn_update_dpp(0, (int)m, CTRL, 0xF, 0xF, true));
            AMX_STEP(0xB1) AMX_STEP(0x4E) AMX_STEP(0x141) AMX_STEP(0x140)
#undef AMX_STEP
#pragma unroll
            for (int e = 0; e < 8; ++e) ck[e] = (ck[e] == m) ? 0u : ck[e];
            const int gi = 127 - (int)(m & 127u);
            sb |= ((gi >> 3) == jj) ? (1u << (gi & 7)) : 0u;
        }
#pragma unroll
        for (int e = 0; e < 8; ++e) { const int j = 8 * jj + e; if (j == 0 || j == jq || j == jq - 1) sb |= 1u << e; }
    } else {
#pragma unroll
        for (int e = 0; e < 8; ++e) if (8 * jj + e <= jq) sb |= 1u << e;
    }
    selB[q2 * 16 + jj] = (unsigned char)sb;
    NSA_LBAR();
    NACC(22);
    const LAS unsigned* selAll = (const LAS unsigned*)(F.lds + NSA_BT_BYTES + 2048);
    unsigned uw[4], mw[4];
#pragma unroll
    for (int w4 = 0; w4 < 4; ++w4) { unsigned u = 0u;
#pragma unroll
        for (int w = 0; w < 8; ++w) { const LAS unsigned* p = selAll + w * (NSA_WAVE_BYTES / 4); u |= p[w4] | p[4 + w4] | p[8 + w4] | p[12 + w4]; }
        uw[w4] = __builtin_amdgcn_readfirstlane(u); mw[w4] = __builtin_amdgcn_readfirstlane(selW[w4] | selW[4 + w4] | selW[8 + w4] | selW[12 + w4]); }
    const unsigned long long uLo = ((unsigned long long)uw[1] << 32) | uw[0], uHi = ((unsigned long long)uw[3] << 32) | uw[2];
    const unsigned long long mLo = ((unsigned long long)mw[1] << 32) | mw[0], mHi = ((unsigned long long)mw[3] << 32) | mw[2];
    const unsigned long long myLo = ((unsigned long long)selW[q * 4 + 1] << 32) | selW[q * 4], myHi = ((unsigned long long)selW[q * 4 + 3] << 32) | selW[q * 4 + 2];
    auto nextbit = [&](int j) -> int {
        const int jn = j + 1; if (jn >= 128) return -1;
        if (jn < 64) { const unsigned long long m = uLo >> jn; if (m) return jn + __builtin_ctzll(m); if (uHi) return 64 + __builtin_ctzll(uHi); return -1; }
        const unsigned long long m = uHi >> (jn - 64); return m ? jn + __builtin_ctzll(m) : -1; };
#define BIT128(lo, hi, j) ((((j) < 64 ? (lo) >> (j) : (hi) >> ((j) - 64)) & 1ull) != 0ull)
#define S_NEXT(j) nextbit(j)
#define S_KPTR(j) (KS + ((size_t)(64 * (j) + srow)) * 64 + scolK)
#define S_VPTR(j) (VST + (size_t)srow * 8192 + 64 * (j) + scol)
#define NCNT(n, cond) ((PROBE2_A == (n) && F.bid == PROBE_WG && F.tid == 0 && (cond)) ? (void)(((volatile LAS unsigned long long*)(F.lds + LDSCTL_OFF + 512))[1] += 100ull) : (void)0)
#define S_ACT(j) (NCNT(30, true), NCNT(31, BIT128(mLo, mHi, j)), BIT128(mLo, mHi, j))
#define S_STEP(j, img) do { const bool ok_ = BIT128(myLo, myHi, j); const float sh_ = nsa_shift(st); \
        if (tq0 - (64 * (j) + 63) >= 1023) { nsa_qk_block(s, qf, kA_, ok_ ? b31 - sh_ : NEGV); }        \
        else { nsa_qk_block(s, qf, kA_, -sh_); \
        float bb_[4][4]; ELEM_LOOP { const int dist = tq - (64 * (j) + KOFF); bb_[t][i] = BTh[BIASIDX(dist)]; } BIAS_PIN(bb_); \
        ELEM_LOOP { const int dist = tq - (64 * (j) + KOFF); s[t][i] = (ok_ && dist >= 0) ? s[t][i] + bb_[t][i] : NEGV; } } \
        nsa_softmax_pv_block(st, s, img, fr, fq, sh_); } while (0)
    att::init(st);
    NSA_PASS(0, S_NEXT, S_KPTR, S_VPTR, true, S_ACT, S_STEP);
    { const float inv = att::finish(st);
#pragma unroll
      for (int mt = 0; mt < 4; ++mt) otot[mt] += st.o[mt] * (inv * gs); }
    NACC(23);
    const int jloW = (t0 > 511 ? t0 - 511 : 0) >> 6, jloM = (tq0 > 511 ? tq0 - 511 : 0) >> 6;
#define W_NEXT(j) (((j) < jq) ? (j) + 1 : -1)
#define W_KPTR(j) (KW + ((size_t)(64 * (j) + srow)) * 64 + scolK)
#define W_VPTR(j) (VWT + (size_t)srow * 8192 + 64 * (j) + scol)
#define W_ACT(j) ((j) >= jloM)
#define W_STEP(j, img) do { const float sh_ = nsa_shift(st); nsa_qk_block(s, qf, kA_, -sh_); \
        float bb_[4][4]; ELEM_LOOP { const int dist = tq - (64 * (j) + KOFF); bb_[t][i] = BTh[BIASIDX(dist)]; } BIAS_PIN(bb_); \
        if (tq0 - (64 * (j) + 63) >= 0 && tq0 + 3 - 64 * (j) < 512) { ELEM_LOOP s[t][i] += bb_[t][i]; }        \
        else ELEM_LOOP { const int dist = tq - (64 * (j) + KOFF); s[t][i] = (dist >= 0 && dist < 512) ? s[t][i] + bb_[t][i] : NEGV; } \
        nsa_softmax_pv_block(st, s, img, fr, fq, sh_); } while (0)
    att::init(st);
    NSA_PASS(jloW, W_NEXT, W_KPTR, W_VPTR, true, W_ACT, W_STEP);
    { const float inv = att::finish(st);
#pragma unroll
      for (int mt = 0; mt < 4; ++mt) otot[mt] += st.o[mt] * (inv * gw); }
    NACC(24);
#pragma unroll
    for (int mt = 0; mt < 4; ++mt) { u32x2 o; o.x = pk2(otot[mt][0], otot[mt][1]); o.y = pk2(otot[mt][2], otot[mt][3]); *(u32x2*)(obase + (size_t)tok * 512 + head * 64 + 16 * mt + 4 * fq) = o; }
#undef BIASIDX
#undef NSA_PASS
#undef C_NEXT
#undef C_KPTR
#undef C_VPTR
#undef C_ACT
#undef C_STEP
#undef I_STEP
#undef BIT128
#undef S_NEXT
#undef S_KPTR
#undef S_VPTR
#undef S_ACT
#undef S_STEP
#undef W_NEXT
#undef W_KPTR
#undef W_VPTR
#undef W_ACT
#undef W_STEP
#undef ELEM_LOOP
#undef KOFF
}
__device__ __forceinline__ void xattn_item(const Frame& F, int l, int t0, bf16_t* obase) {
    const int lane = F.lane, fr = lane & 15, fq = lane >> 4, half = F.wave >> 2, head = F.wave & 3;
    const int tok = t0 + 16 * half + fr, b = tok >> 13;
    const bf16_t* qx = (const bf16_t*)(F.ws + WS_Z + Z_QX);
    const bf16_t* K = (const bf16_t*)(F.ws + WS_XKV) + ((size_t)l * 1024 + b * 256) * 512 + head * 128;
    const bf16_t* VT = (const bf16_t*)(F.ws + WS_XKV) + (size_t)2 * 1024 * 512 + ((size_t)(l * 4 + b) * 4 + head) * 128 * 256;
    bf16x8 qf[4];
#pragma unroll
    for (int ks = 0; ks < 4; ++ks) qf[ks] = *(const bf16x8*)(qx + (size_t)tok * 512 + head * 128 + 32 * ks + 8 * fq);
    att::St<128> st; att::init(st); f32x4 s[2]; att::KV<128> A, B;
#define XLOAD(kv, kap) do { att::load_k<128>(kv, K + (size_t)32 * (kap) * 512, 512, fr, fq); att::load_v<128>(kv, VT + 32 * (kap), 256, fr, fq); } while (0)
    XLOAD(A, 0);
    for (int kap = 0; kap < 8; kap += 2) {
        XLOAD(B, kap + 1);
        att::qk<128>(s, qf, A); att::softmax_pv<128>(st, s, A);
        if (kap + 2 < 8) XLOAD(A, kap + 2);
        att::qk<128>(s, qf, B); att::softmax_pv<128>(st, s, B);
    }
#undef XLOAD
    const float inv = att::finish(st);
#pragma unroll
    for (int mt = 0; mt < 8; ++mt) { const f32x4 v = st.o[mt] * inv; u32x2 o; o.x = pk2(v[0], v[1]); o.y = pk2(v[2], v[3]); *(u32x2*)(obase + (size_t)tok * 512 + head * 128 + 16 * mt + 4 * fq) = o; }
}


__device__ __forceinline__ void lora_prep(const Frame& F, int l, int widx, int nw) {
    constexpr int NG = NTOK / 16, NIT = 7 * NG;
    const int lane = F.lane, c0 = 4 * lane;
    const float* mub = inp(F, I_MU) + (size_t)l * 1792;
#define LP_ADDR(it_) const int ps_ = (it_) / NG, g_ = (it_) - ps_ * NG, cc_ = ps_ ? 256 * (ps_ - 1) + c0 : c0, pitch_ = ps_ ? 1536 : 256; \
        const size_t base_ = (ps_ ? (WS_Z + Z_RKV) : (WS_Z + Z_ZL)) + ((size_t)(16 * g_) * pitch_ + cc_) * 2, halo_ = (ps_ ? WS_RKH : (WS_Z + Z_ZLH)) + ((size_t)(g_ - 1) * pitch_ + cc_) * 2
#define LP_LOAD(R, it_) do { LP_ADDR(it_); \
        _Pragma("unroll") for (int i = 0; i < 16; ++i) R[i + 1] = *(const u32x2*)(F.ws + base_ + (size_t)i * pitch_ * 2); \
        R[0] = ((g_ & (SEQ / 16 - 1)) == 0) ? (u32x2){0u, 0u} : *(const u32x2*)(F.ws + halo_); } while (0)
#define LP_DO(R, it_) do { LP_ADDR(it_); (void)halo_; const f32x4 m4 = *(const f32x4*)(mub + (ps_ ? cc_ : 1536 + c0)); \
        if (ps_ == 0) { \
            _Pragma("unroll") for (int i = 0; i < 16; ++i) { float y[4]; \
                const float c[4] = {bflo(R[i + 1].x), bfhi(R[i + 1].x), bflo(R[i + 1].y), bfhi(R[i + 1].y)}, p[4] = {bflo(R[i].x), bfhi(R[i].x), bflo(R[i].y), bfhi(R[i].y)}; \
                _Pragma("unroll") for (int e = 0; e < 4; ++e) { const float v = c[e] + m4[e] * (p[e] - c[e]); const float sg = sigmoidf_((c0 < 64) ? 2.f * v : v);        \
                    y[e] = (c0 < 64) ? 2.f * sg - 1.f : ((c0 < 128) ? v : sg); } \
                u32x2 o; o.x = pk2(y[0], y[1]); o.y = pk2(y[2], y[3]); *(u32x2*)(F.ws + base_ + (size_t)i * pitch_ * 2) = o; } \
        } else { \
            _Pragma("unroll") for (int i = 0; i < 16; ++i) { float y[4]; \
                const float c[4] = {bflo(R[i + 1].x), bfhi(R[i + 1].x), bflo(R[i + 1].y), bfhi(R[i + 1].y)}, p[4] = {bflo(R[i].x), bfhi(R[i].x), bflo(R[i].y), bfhi(R[i].y)}; \
                _Pragma("unroll") for (int e = 0; e < 4; ++e) y[e] = c[e] + m4[e] * (p[e] - c[e]); \
                u32x2 o; o.x = pk2(y[0], y[1]); o.y = pk2(y[2], y[3]); *(u32x2*)(F.ws + base_ + (size_t)i * pitch_ * 2) = o; } } } while (0)
    u32x2 ra[17], rb[17];
    int it = widx; if (it < NIT) LP_LOAD(ra, it);
#pragma unroll 1
    for (; it < NIT; it += 2 * nw) {
        const int it2 = it + nw, it3 = it2 + nw;
        if (it2 < NIT) LP_LOAD(rb, it2);
        LP_DO(ra, it);
        if (it3 < NIT) LP_LOAD(ra, it3);
        if (it2 < NIT) LP_DO(rb, it2);
    }
#undef LP_ADDR
#undef LP_LOAD
#undef LP_DO
}


__device__ __forceinline__ void xattn_lds_item(const Frame& F, int l, int item) {
    const int lane = F.lane, fr = lane & 15, fq = lane >> 4, b = item >> 6, head = (item >> 4) & 3, chunk = item & 15;
    bf16_t* qx = (bf16_t*)(F.ws + WS_Z + Z_QX);
    const __amdgpu_buffer_rsrc_t rsrc = __builtin_amdgcn_make_buffer_rsrc((void*)F.ws, 0, 0x7ffffff0, 0x00020000);
    const unsigned oK = (unsigned)WS_XKV + (unsigned)(((size_t)l * 1024 + b * 256) * 512 + head * 128) * 2u;
    const unsigned oV = (unsigned)WS_XKV + (unsigned)((size_t)2 * 1024 * 512 + ((size_t)(l * 4 + b) * 4 + head) * 128 * 256) * 2u;
    __syncthreads();
#pragma unroll
    for (int i = 0; i < 8; ++i) { const int I = F.wave * 8 + i;
        const int r = 4 * I + (lane >> 4), c = (lane & 15) ^ ((r & 3) | (((r >> 3) & 3) << 2));
        __builtin_amdgcn_raw_ptr_buffer_load_lds(rsrc, (LAS void*)(F.lds + I * 1024), 16, (int)(oK + (unsigned)(r * 1024 + c * 16)), 0, 0, 0); }
#pragma unroll
    for (int i = 0; i < 8; ++i) { const int I = F.wave * 8 + i;
        const int d = 2 * I + (lane >> 5), c = (lane & 31) ^ (d & 15);
        __builtin_amdgcn_raw_ptr_buffer_load_lds(rsrc, (LAS void*)(F.lds + 65536 + I * 1024), 16, (int)(oV + (unsigned)(d * 512 + c * 16)), 0, 0, 0); }
    asm volatile("s_waitcnt vmcnt(0)" ::: "memory"); __syncthreads();
    const LAS unsigned char* KI = F.lds; const LAS unsigned char* VI = F.lds + 65536;
#pragma unroll 1
    for (int tile = 0; tile < 4; ++tile) {
        const int tok = b * SEQ + chunk * 512 + (F.wave * 4 + tile) * 16 + fr;
        bf16x8 qf[4];
#pragma unroll
        for (int ks = 0; ks < 4; ++ks) qf[ks] = *(const bf16x8*)(qx + (size_t)tok * 512 + head * 128 + 32 * ks + 8 * fq);
        att::St<128> st; att::init(st);
#pragma unroll 1
        for (int kap = 0; kap < 8; ++kap) {
            att::KV<128> kv;
#pragma unroll
            for (int tau = 0; tau < 2; ++tau) { const int row = 32 * kap + 8 * (fr >> 2) + 4 * tau + (fr & 3);
#pragma unroll
                for (int ks = 0; ks < 4; ++ks) kv.k[tau][ks] = *(const LAS bf16x8*)(KI + row * 256 + (((4 * ks + fq) ^ ((row & 3) | (((row >> 3) & 3) << 2))) << 4)); }
#pragma unroll
            for (int mt = 0; mt < 8; ++mt) { const int d = 16 * mt + fr; kv.v[mt] = *(const LAS bf16x8*)(VI + d * 512 + (((4 * kap + fq) ^ (d & 15)) << 4)); }
            f32x4 s2[2]; att::qk<128>(s2, qf, kv); att::softmax_pv<128>(st, s2, kv);
        }
        const float inv = att::finish(st);
#pragma unroll
        for (int mt = 0; mt < 8; ++mt) { const f32x4 v = st.o[mt] * inv; u32x2 o; o.x = pk2(v[0], v[1]); o.y = pk2(v[2], v[3]); *(u32x2*)(qx + (size_t)tok * 512 + head * 128 + 16 * mt + 4 * fq) = o; }
    }
}

namespace scan2 {
constexpr int TC = 32, ALP = 296, RP = 72, LP = 68, GP = 68;
constexpr int LARR = TC * LP * 4;
constexpr int O_AL = 0,
              O_QK = 0,
              O_LW = 18944, O_OUT = O_LW,
              O_LA = O_LW + LARR, O_LVG = O_LA + LARR, O_CUM = O_LVG + LARR,
              O_LG = O_CUM + LARR,
              O_VP = O_LG + 2 * TC * GP * 2,
              O_PR = O_VP + 2 * TC * 64 * 2,
              O_QKB = O_PR + 2 * 2 * 32 * RP * 2,
              O_VT = O_QKB + 2 * 2 * 64 * 40 * 2,
              O_FR = O_VT + 2 * 2 * 64 * 20 * 2,
              O_END = O_FR + 2 * 2 * 2048,
              O_PRM = LDSCTL_OFF + 4096,
              O_GC = O_PRM + 16 * 48 * 4,
              O_SC = O_GC + 1024;
static_assert(O_SC + 256 <= LDS_BYTES, "scan2 lds ctl");
static_assert(O_END <= RING_BYTES, "scan2 lds");
struct Raw { u32x2 zw, za, r, k, v; u32x4 zg; unsigned va, vb; u32x2 vf; };
__device__ __forceinline__ float mixf(float c, float p, float mu) { return c + mu * (p - c); }
__device__ __forceinline__ u32x2 pk4(const f32x4& v) { u32x2 o; o.x = pg8::cvt_pk_bf16(v[0], v[1]); o.y = pg8::cvt_pk_bf16(v[2], v[3]); return o; }
__device__ __forceinline__ bf16x8 mk8(const u32x2 lo, const u32x2 hi) { u32x4 w; w.x = lo.x; w.y = lo.y; w.z = hi.x; w.w = hi.y; return __builtin_bit_cast(bf16x8, w); }
#define LBAR() asm volatile("s_waitcnt lgkmcnt(0)\n\ts_barrier" ::: "memory")
#define MF16(a, b, c) __builtin_amdgcn_mfma_f32_16x16x32_bf16((a), (b), (c), 0, 0, 0)
#define PACC(n) do { if (PROBE2_A >= 10 && l == PROBE_L && F.bid == PROBE_WG && F.tid == 0) { const unsigned long long t_ = __builtin_amdgcn_s_memrealtime(); volatile LAS unsigned long long* pm_ = (volatile LAS unsigned long long*)(F.lds + LDSCTL_OFF + 512); \
    if ((n) == PROBE2_A) pm_[0] = t_; if ((n) == PROBE2_B) pm_[1] += t_ - pm_[0]; } } while (0)
__device__ __forceinline__ f32x4 mm16(const f32x4& yt, const f32x4& z) { const u32x2 zz = {0u, 0u}; return MF16(mk8(pk4(yt), zz), mk8(pk4(z), zz), ((f32x4){0.f, 0.f, 0.f, 0.f})); }

__device__ __forceinline__ void run(const Frame& F, const Args& a, int l, int bh) {
    const int b = bh >> 3, h = bh & 7, tid = F.tid, lane = F.lane, wave = F.wave;
    const int tl = tid >> 4, cg = tid & 15;
    const int fr = lane & 15, fq = lane >> 4, mt = wave >> 2, nt = wave & 3;
    LAS unsigned char* L = F.lds;
    LAS bf16_t* AL = (LAS bf16_t*)(L + O_AL);
    LAS float *LW = (LAS float*)(L + O_LW), *LA = (LAS float*)(L + O_LA), *LVG = (LAS float*)(L + O_LVG), *OUT = (LAS float*)(L + O_OUT),
              *SC = (LAS float*)(L + O_SC), *GC = (LAS float*)(L + O_GC), *CUM = (LAS float*)(L + O_CUM);
    LAS bf16_t *PR = (LAS bf16_t*)(L + O_PR), *QK = (LAS bf16_t*)(L + O_QK), *QKB = (LAS bf16_t*)(L + O_QKB), *VT = (LAS bf16_t*)(L + O_VT), *LG = (LAS bf16_t*)(L + O_LG), *VP = (LAS bf16_t*)(L + O_VP);
    LAS unsigned char* FR = L + O_FR;
    const GAS bf16_t* zl = (const GAS bf16_t*)(F.ws + WS_Z + Z_ZL); const GAS bf16_t* rkv = (const GAS bf16_t*)(F.ws + WS_Z + Z_RKV); const GAS bf16_t* vab = (const GAS bf16_t*)(F.ws + WS_Z + Z_VAB);
    GAS bf16_t* vfb = (GAS bf16_t*)(F.ws + WS_VF); GAS bf16_t* orw = (GAS bf16_t*)(F.ws + WS_Z + Z_ORW);
    LAS float* PRM = (LAS float*)(L + O_PRM);
    { const float* mu = inp(F, I_MU) + (size_t)l * 1792;
      for (int i = tid; i < 16 * 48; i += 512) { const int g_ = i / 48, k = i % 48, e = k & 3, j = 64 * h + 4 * g_ + e; float v;
          if (k < 4) v = mu[j]; else if (k < 8) v = mu[512 + j]; else if (k < 12) v = mu[1024 + j]; else if (k < 16) v = mu[1536 + 4 * g_ + e]; else if (k < 20) v = mu[1600 + 4 * g_ + e];
          else if (k < 28) v = mu[1664 + 8 * g_ + (k - 20)]; else if (k < 32) v = inp(F, I_KK)[l * 512 + j]; else if (k < 36) v = inp(F, I_KA)[l * 512 + j]; else if (k < 40) v = inp(F, I_RK)[l * 512 + j];
          else if (k < 44) v = inp(F, I_GNG)[l * 512 + j]; else v = inp(F, I_GNB)[l * 512 + j];
          PRM[i] = v; } }
    __syncthreads();
    const LAS f32x4* PR4 = (const LAS f32x4*)(PRM + cg * 48);
#define PRMV(name, idx) const f32x4 name = PR4[idx]
    bf16x8 Bw[2], Ba[2], Bg[4], Bv;
    { const int col = 64 * h + 16 * nt + fr; const float* w2 = inp(F, I_W2) + (size_t)l * 64 * 512; const float* a2 = inp(F, I_A2) + (size_t)l * 64 * 512; const float* g2 = inp(F, I_G2) + (size_t)l * 128 * 512;
#pragma unroll
      for (int ks = 0; ks < 2; ++ks)
#pragma unroll
          for (int e = 0; e < 8; ++e) { const int k = 32 * ks + 8 * fq + e; Bw[ks][e] = (short)f2bf(w2[(size_t)k * 512 + col]); Ba[ks][e] = (short)f2bf(a2[(size_t)k * 512 + col]); }
#pragma unroll
      for (int ks = 0; ks < 4; ++ks)
#pragma unroll
          for (int e = 0; e < 8; ++e) { const int k = 32 * ks + 8 * fq + e; Bg[ks][e] = (short)f2bf(g2[(size_t)k * 512 + col]); }
#pragma unroll
      for (int e = 0; e < 8; ++e) { const int k = 8 * fq + e; Bv[e] = (l > 0) ? (short)f2bf(inp(F, I_V2)[(size_t)(l - 1) * 32 * 512 + (size_t)k * 512 + col]) : (short)0; } }
    const f32x4 w0q = *(const f32x4*)(inp(F, I_W0) + l * 512 + 64 * h + 16 * nt + 4 * fq), a0q = *(const f32x4*)(inp(F, I_A0) + l * 512 + 64 * h + 16 * nt + 4 * fq);
    f32x4 v0q = {0.f, 0.f, 0.f, 0.f}; if (l > 0) v0q = *(const f32x4*)(inp(F, I_V0) + (l - 1) * 512 + 64 * h + 16 * nt + 4 * fq);
    f32x4 S[4];
#pragma unroll
    for (int m = 0; m < 4; ++m) S[m] = (f32x4){0.f, 0.f, 0.f, 0.f};
    Raw rw0, rw1;
#define LOAD_RAW_A(raw, c_) do { const int t_ = (c_) * TC + tl; const size_t tok_ = (size_t)b * SEQ + t_; \
        raw.zw = *(const GAS u32x2*)(zl + tok_ * 256 + 4 * cg); raw.za = *(const GAS u32x2*)(zl + tok_ * 256 + 64 + 4 * cg); raw.zg = *(const GAS u32x4*)(zl + tok_ * 256 + 128 + 8 * cg); \
        if (l > 0) { raw.va = *(const GAS unsigned*)(vab + tok_ * 64 + 2 * cg); raw.vb = (t_ == 0) ? 0u : *(const GAS unsigned*)(vab + (tok_ - 1) * 64 + 32 + 2 * cg); } else { raw.va = 0u; raw.vb = 0u; } } while (0)
#define LOAD_RAW_B(raw, c_) do { const int t_ = (c_) * TC + tl; const size_t tok_ = (size_t)b * SEQ + t_; \
        raw.r = *(const GAS u32x2*)(rkv + tok_ * 1536 + 64 * h + 4 * cg); raw.k = *(const GAS u32x2*)(rkv + tok_ * 1536 + 512 + 64 * h + 4 * cg); raw.v = *(const GAS u32x2*)(rkv + tok_ * 1536 + 1024 + 64 * h + 4 * cg); \
        if (l > 0) raw.vf = *(const GAS u32x2*)(vfb + tok_ * 512 + 64 * h + 4 * cg); else raw.vf = (u32x2){0u, 0u}; } while (0)
#define LOAD_RAW(raw, c_) do { LOAD_RAW_A(raw, c_); LOAD_RAW_B(raw, c_); } while (0)
    LOAD_RAW(rw0, 0); LOAD_RAW(rw1, 1);
#define UNP4(dst, w) dst[0] = bflo((w).x); dst[1] = bfhi((w).x); dst[2] = bflo((w).y); dst[3] = bfhi((w).y)
#define STAGE1(R) do { *(LAS u32x2*)(AL + tl * ALP + 4 * cg) = R.zw; *(LAS u32x2*)(AL + tl * ALP + 64 + 4 * cg) = R.za; *(LAS u32x4*)(AL + tl * ALP + 128 + 8 * cg) = R.zg; \
        *(LAS unsigned*)(AL + tl * ALP + 256 + 2 * cg) = pk2(bflo(R.va) + bflo(R.vb), bfhi(R.va) + bfhi(R.vb)); } while (0)
    STAGE1(rw0);
    VM_WAIT();
    LBAR();
    constexpr int NR = SEQ / TC;
    static_assert((NR & 1) == 0, "round count");
#pragma unroll 1
    for (int c2 = 0; c2 <= NR; c2 += 2) {
#pragma unroll
      for (int hh = 0; hh < 2; ++hh) {
        const int c = c2 + hh; if (c > NR) break;
        Raw& raw = hh ? rw1 : rw0; Raw& rawn = hh ? rw0 : rw1;
        const int p = c & 1, q = p ^ 1;
        PACC(10);
        LOAD_RAW_A(raw, (c + 2 < NR ? c + 2 : NR - 1));
        { f32x4 wl = {0.f, 0.f, 0.f, 0.f}, al = wl, gl = wl, vgl = wl;
          const LAS bf16_t* ar = AL + (16 * mt + fr) * ALP + 8 * fq;
#pragma unroll
          for (int ks = 0; ks < 2; ++ks) wl = MF16(Bw[ks], *(const LAS bf16x8*)(ar + 32 * ks), wl);
#pragma unroll
          for (int ks = 0; ks < 2; ++ks) al = MF16(Ba[ks], *(const LAS bf16x8*)(ar + 64 + 32 * ks), al);
#pragma unroll
          for (int ks = 0; ks < 4; ++ks) gl = MF16(Bg[ks], *(const LAS bf16x8*)(ar + 128 + 32 * ks), gl);
          if (l > 0) vgl = MF16(Bv, *(const LAS bf16x8*)(ar + 256), vgl);
          f32x4 lw4, cs4, la4, vg4;
#pragma unroll
          for (int i = 0; i < 4; ++i) { lw4[i] = -0.6065306597126334f * LOG2E * sigmoidf_(w0q[i] + wl[i]); la4[i] = sigmoidf_(a0q[i] + al[i]); vg4[i] = sigmoidf_(v0q[i] + vgl[i]); }
#pragma unroll
          for (int i = 0; i < 4; ++i) { float v = lw4[i]; v += dppf<0x111>(v); v += dppf<0x112>(v); v += dppf<0x114>(v); v += dppf<0x118>(v); cs4[i] = v; }
          const int o = (16 * mt + fr) * LP + 16 * nt + 4 * fq;
          *(LAS f32x4*)(LW + o) = lw4; *(LAS f32x4*)(CUM + o) = cs4; *(LAS f32x4*)(LA + o) = la4; *(LAS f32x4*)(LVG + o) = vg4;
          *(LAS u32x2*)(LG + (p * TC + 16 * mt + fr) * GP + 16 * nt + 4 * fq) = pk4(gl);
          if (fr == 15) { f32x4 g;
#pragma unroll
              for (int i = 0; i < 4; ++i) g[i] = ex2(cs4[i]);
              *(LAS f32x4*)(GC + (p * 2 + mt) * 64 + 16 * nt + 4 * fq) = g; } }
        LBAR();
        PACC(11);
        { const size_t tok = (size_t)b * SEQ + (c < NR ? c : NR - 1) * TC + tl;
          const int ch = tl >> 4, t = tl & 15, oL = tl * LP + 4 * cg; const f32x4 av = *(const LAS f32x4*)(LA + oL), vg = *(const LAS f32x4*)(LVG + oL);
          const f32x4 cum = *(const LAS f32x4*)(CUM + oL), lwt = *(const LAS f32x4*)(LW + oL), gct = *(const LAS f32x4*)(GC + (p * 2 + ch) * 64 + 4 * cg);
          float rm[4], km[4], vm[4]; UNP4(rm, raw.r); UNP4(km, raw.k); UNP4(vm, raw.v);
          float vf4[4]; UNP4(vf4, raw.vf); PRMV(kkw, 7); PRMV(kaw, 8); PRMV(rkw, 9);
          LOAD_RAW_B(raw, (c + 2 < NR ? c + 2 : NR - 1));
          f32x4 kk4, kp4, vp4; float n2 = 0.f;
#pragma unroll
          for (int e = 0; e < 4; ++e) { vp4[e] = (l > 0) ? vm[e] + (vf4[e] - vm[e]) * vg[e] : vm[e]; const float kx = km[e] * kkw[e]; kk4[e] = kx; n2 += kx * kx; }
          if (l == 0) { u32x2 o; o.x = pk2(vm[0], vm[1]); o.y = pk2(vm[2], vm[3]); *(GAS u32x2*)(vfb + tok * 512 + 64 * h + 4 * cg) = o; }
          n2 = red16(n2); const float invn = rsqf(fmaxf(n2, 1e-24f));
          float bs = 0.f; f32x4 pt, rt, qh, kh, qb, kb;
#pragma unroll
          for (int e = 0; e < 4; ++e) { kk4[e] *= invn; kp4[e] = km[e] * (1.f + (av[e] - 1.f) * kaw[e]); bs += rm[e] * kp4[e] * rkw[e];
              const float gi = ex2(cum[e]), gp = ex2(cum[e] - lwt[e]), ginv = rcpf(gi), gr = gct[e] * ginv, qv = kk4[e] * av[e];
              pt[e] = -kk4[e] * gp; rt[e] = rm[e] * gi; qh[e] = qv * ginv; kh[e] = kp4[e] * ginv; qb[e] = qv * gr; kb[e] = kp4[e] * gr; }
          bs = red16(bs);
          const int pc = p * 2 + ch;
          *(LAS u32x2*)(PR + (pc * 32 + t) * RP + 4 * cg) = pk4(pt); *(LAS u32x2*)(PR + (pc * 32 + 16 + t) * RP + 4 * cg) = pk4(rt);
          *(LAS u32x2*)(QK + (ch * 32 + t) * RP + 4 * cg) = pk4(qh); *(LAS u32x2*)(QK + (ch * 32 + 16 + t) * RP + 4 * cg) = pk4(kh);
          { LAS bf16_t* qd = QKB + (pc * 64 + 4 * cg) * 40 + 8 * ((t >> 2) ^ ((cg >> 1) & 3)) + (t & 3); LAS bf16_t* vd = VT + (pc * 64 + 4 * cg) * 20 + 4 * ((t >> 2) ^ (cg >> 2)) + (t & 3);
            const unsigned v01 = pk2(vp4[0], vp4[1]), v23 = pk2(vp4[2], vp4[3]);
            vd[0] = (bf16_t)(v01 & 0xffffu); vd[20] = (bf16_t)(v01 >> 16); vd[40] = (bf16_t)(v23 & 0xffffu); vd[60] = (bf16_t)(v23 >> 16);
            { u32x2 w; w.x = v01; w.y = v23; *(LAS u32x2*)(VP + (p * TC + tl) * 64 + 4 * cg) = w; }
#pragma unroll
            for (int e = 0; e < 4; ++e) { const unsigned w = pk2(qb[e], kb[e]); qd[e * 40] = (bf16_t)(w & 0xffffu); qd[e * 40 + 4] = (bf16_t)(w >> 16); } }
          if (cg == 0) SC[p * TC + tl] = bs; }
        LBAR();
        PACC(12);
        if (wave >= 4) { { const int ch = wave & 1; const f32x4 z4 = {0.f, 0.f, 0.f, 0.f};
            const LAS bf16_t* pP = PR + ((p * 2 + ch) * 32 + fr) * RP + 8 * fq; const LAS bf16_t* pR = pP + 16 * RP; const LAS bf16_t* pQ = QK + (ch * 32 + fr) * RP + 8 * fq; const LAS bf16_t* pK = pQ + 16 * RP;
            LAS unsigned char* fr_ = FR + (p * 2 + ch) * 2048;
            if (wave < 6) {
                bf16x8 fP[2], fQ[2];
#pragma unroll
                for (int ks = 0; ks < 2; ++ks) { fP[ks] = *(const LAS bf16x8*)(pP + 32 * ks); fQ[ks] = *(const LAS bf16x8*)(pQ + 32 * ks); }
                f32x4 X = MF16(fP[1], fQ[1], MF16(fP[0], fQ[0], z4));
                f32x4 XT = MF16(fQ[1], fP[1], MF16(fQ[0], fP[0], z4));
                f32x4 ID;
#pragma unroll
                for (int i = 0; i < 4; ++i) { const int row = 4 * fq + i, col = fr;
                    X[i] = (col < row) ? X[i] : 0.f;
                    XT[i] = (row < col) ? XT[i] : 0.f;
                    ID[i] = (row == col) ? 1.f : 0.f; }
                const f32x4 X2 = mm16(XT, X), X2T = mm16(X, XT);
                const f32x4 X4 = mm16(X2T, X2), X4T = mm16(X2, X2T);
                const f32x4 X8 = mm16(X4T, X4);
                const f32x4 T1T = mm16(ID + X2, ID + XT);
                const f32x4 T2T = mm16(ID + X4, T1T);
                const f32x4 T3T = mm16(ID + X8, T2T);
                *(LAS u32x2*)(fr_ + lane * 8) = pk4(T3T);
            } else {
                bf16x8 fP[2], fR[2], fQ[2], fK[2];
#pragma unroll
                for (int ks = 0; ks < 2; ++ks) { fP[ks] = *(const LAS bf16x8*)(pP + 32 * ks); fR[ks] = *(const LAS bf16x8*)(pR + 32 * ks); fQ[ks] = *(const LAS bf16x8*)(pQ + 32 * ks); fK[ks] = *(const LAS bf16x8*)(pK + 32 * ks); }
                f32x4 PKT = MF16(fK[1], fP[1], MF16(fK[0], fP[0], z4));
                f32x4 RQT = MF16(fQ[1], fR[1], MF16(fQ[0], fR[0], z4));
                f32x4 RKT = MF16(fK[1], fR[1], MF16(fK[0], fR[0], z4));
#pragma unroll
                for (int i = 0; i < 4; ++i) { const int row = 4 * fq + i, col = fr;
                    PKT[i] = (row < col) ? PKT[i] : 0.f; RQT[i] = (row <= col) ? RQT[i] : 0.f; RKT[i] = (row <= col) ? RKT[i] : 0.f; }
                *(LAS u32x2*)(fr_ + 512 + lane * 8) = pk4(PKT);
                { const u32x2 lo = pk4(RQT), hi = pk4(RKT); u32x4 w; w.x = lo.x; w.y = lo.y; w.z = hi.x; w.w = hi.y; *(LAS u32x4*)(fr_ + 1024 + lane * 16) = w; }
            } }
        }
        else if (c > 0) {
#pragma unroll 1
            for (int ch = 0; ch < 2; ++ch) {
                const u32x2 zz = {0u, 0u}; const f32x4 z4 = {0.f, 0.f, 0.f, 0.f}; const int qc = q * 2 + ch;
                bf16x8 Sb[2];
#pragma unroll
                for (int kp = 0; kp < 2; ++kp) Sb[kp] = mk8(pk4(S[2 * kp]), pk4(S[2 * kp + 1]));
                const LAS bf16_t* pP = PR + (qc * 32 + fr) * RP + 4 * fq; const LAS bf16_t* pR = pP + 16 * RP;
                f32x4 x = z4, o = z4;
#pragma unroll
                for (int kp = 0; kp < 2; ++kp) { const bf16x8 aP = mk8(*(const LAS u32x2*)(pP + 32 * kp), *(const LAS u32x2*)(pP + 32 * kp + 16)), aR = mk8(*(const LAS u32x2*)(pR + 32 * kp), *(const LAS u32x2*)(pR + 32 * kp + 16));
                    x = MF16(aP, Sb[kp], x); o = MF16(aR, Sb[kp], o); }
                const LAS unsigned char* fr_ = FR + qc * 2048;
                const u32x2 vfrag = *(const LAS u32x2*)(VT + (qc * 64 + 16 * wave + fr) * 20 + 4 * (fq ^ wave));
                x = MF16(mk8(*(const LAS u32x2*)(fr_ + 512 + lane * 8), zz), mk8(vfrag, zz), x);
                const f32x4 u = MF16(mk8(*(const LAS u32x2*)(fr_ + lane * 8), zz), mk8(pk4(x), zz), z4);
                const bf16x8 UV = mk8(pk4(u), vfrag);
                o = MF16(__builtin_bit_cast(bf16x8, *(const LAS u32x4*)(fr_ + 1024 + lane * 16)), UV, o);
#pragma unroll
                for (int m = 0; m < 4; ++m) { const f32x4 gc = *(const LAS f32x4*)(GC + qc * 64 + 16 * m + 4 * fq);
                    S[m] = MF16(*(const LAS bf16x8*)(QKB + (qc * 64 + 16 * m + fr) * 40 + 8 * (fq ^ ((2 * m + (fr >> 3)) & 3))), UV, S[m] * gc); }
#pragma unroll
                for (int i = 0; i < 4; ++i) OUT[(16 * ch + 4 * fq + i) * 64 + 16 * wave + fr] = o[i];
            }
        }
        LBAR();
        PACC(13);
        { const size_t tok = (size_t)b * SEQ + (c > 0 ? c - 1 : 0) * TC + tl;
          const int o4 = tl * 64 + 4 * cg; const f32x4 ov = *(const LAS f32x4*)(OUT + o4); const u32x2 vw = *(const LAS u32x2*)(VP + (q * TC + tl) * 64 + 4 * cg), gw = *(const LAS u32x2*)(LG + (q * TC + tl) * GP + 4 * cg); const float bs = SC[q * TC + tl];
          float vp4[4], g4[4]; UNP4(vp4, vw); UNP4(g4, gw);
          const float mean = red16((ov[0] + ov[1]) + (ov[2] + ov[3])) * (1.f / 64.f); f32x4 d = ov - mean;
          const float var = red16((d[0] * d[0] + d[1] * d[1]) + (d[2] * d[2] + d[3] * d[3])) * (1.f / 64.f); const float rs = rsqf(var + GN_EPS);
          PRMV(gng, 10); PRMV(gnb, 11);
          float y[4];
#pragma unroll
          for (int e = 0; e < 4; ++e) y[e] = ((d[e] * rs) * gng[e] + gnb[e] + bs * vp4[e]) * g4[e];
          u32x2 o; o.x = pk2(y[0], y[1]); o.y = pk2(y[2], y[3]); *(GAS u32x2*)(orw + tok * 512 + 64 * h + 4 * cg) = o; }
        STAGE1(rawn);
        LBAR();
        PACC(14);
      }
    }
#undef STAGE1
#undef UNP4
    __syncthreads();
#undef PRMV
#undef LOAD_RAW
}
#undef MF16
}

#ifndef MK_SPLIT
#define MK_SPLIT 0
#endif
constexpr int PH_PER_LAYER = 16, N_PHASES = 1 + NLAYER * PH_PER_LAYER;

#ifndef PHMASK
#define PHMASK 0xFFFFFFFFu
#endif
#define PMARK(n) do { if (PROBE2_A >= 0 && l == PROBE_L && F.bid == PROBE_WG && F.tid == 0) { const unsigned long long t_ = __builtin_amdgcn_s_memrealtime(); volatile LAS unsigned long long* pm_ = (volatile LAS unsigned long long*)(F.lds + LDSCTL_OFF + 512); \
    if ((n) == PROBE2_A) pm_[0] = t_; if ((n) == PROBE2_B) pm_[1] = t_ - pm_[0]; } } while (0)
#define PHON(k) ((PHMASK >> (k)) & 1u)
#if MK_SPLIT
#define IN(k) (lo <= (k) && (k) < hi)
#else
#define IN(k) ((k) < N_PHASES)
#endif
#define PH_BEGIN() do { asm volatile("" : "+v"(F.tid)); asm volatile("" : "+s"(F.ws)); asm volatile("" : "+s"(X)); F.ws = as_global(F.ws); X = as_global(X); F.lane = F.tid & 63; F.wave = __builtin_amdgcn_readfirstlane(F.tid >> 6); } while (0)
#define SEAM(k) do { if (IN((k) + 1)) { XcdBarrier b_ = bar; asm volatile("" : "+s"(b_.bar)); xcd_barrier(b_); } \
    if (PROBE_ID >= 0) { const unsigned long long tn_ = __builtin_amdgcn_s_memrealtime(); if ((k) == PROBE_ID) probe_dt = tn_ - probe_prev; probe_prev = tn_; } } while (0)
template <int l>
__device__ __forceinline__ bool layer_body(Frame& F, const Args& args, float*& X, const XcdBarrier& bar, LAS int* PE, const int G, const int bid, unsigned long long& probe_prev, unsigned long long& probe_dt) {
        const int pb = 1 + l * PH_PER_LAYER;
        if (PHON(1) && IN(pb + 0)) { PH_BEGIN();
            { pg8::Gemm g{(bf16_t*)(F.ws + WS_XB), (bf16_t*)(F.ws + WS_W) + W_IN / 2 + (size_t)l * 3328 * 1024, 1024, 1024, nullptr, nullptr}; pg8::GridOrder S; S.init(NTOK, 3328, G, bid);
              epi::InProj E{(bf16_t*)(F.ws + WS_Z + Z_QB), (bf16_t*)(F.ws + WS_Z + Z_KV6), (bf16_t*)(F.ws + WS_Z + Z_ZL), (bf16_t*)(F.ws + WS_Z + Z_RKV), (float*)(F.ws + WS_Z + Z_GN), (bf16_t*)(F.ws + WS_Z + Z_VAB), (bf16_t*)(F.ws + WS_Z + Z_ZLH), (bf16_t*)(F.ws + WS_RKH)};
              pg8::gemm_phase(F.lds, F.tid, F.ws, g, S, E); }
            { pg8::Gemm g{(bf16_t*)(F.ws + WS_W) + W_MEM / 2, (bf16_t*)(F.ws + WS_W) + W_XKV / 2 + (size_t)l * 1024 * 1024, 1024, 1024, nullptr, nullptr}; pg8::GridOrder S; S.init(1024, 1024, G, bid - G / 2);
              epi::MemKV E{(bf16_t*)(F.ws + WS_XKV) + (size_t)l * 1024 * 512, (bf16_t*)(F.ws + WS_XKV) + (size_t)2 * 1024 * 512 + (size_t)l * 16 * 128 * 256};
              pg8::gemm_phase(F.lds, F.tid, F.ws, g, S, E); }
            SEAM(pb + 0);
        }
        if (PHON(4) && IN(pb + 3)) { PH_BEGIN();
            unsigned* lcnt = (unsigned*)(F.ws + WS_CTL) + CW_LPR + 64 * l;
            PMARK(0);
            if (bid < 32 || bid >= 64) {
                lora_prep(F, l, (bid < 32 ? bid : bid - 32) * 8 + F.wave, (G - 32) * 8); VM_WAIT(); __syncthreads();
                if (F.tid == 0) { __builtin_amdgcn_fence(__ATOMIC_RELEASE, "agent"); VM_WAIT(); __hip_atomic_fetch_add(lcnt, 1u, RLX_AGENT); }
            }
#ifndef NO_SCAN
            if (bid < 32) {
                { if (F.tid == 0) { unsigned sp = 0u; while (__hip_atomic_load(lcnt, RLX_AGENT) < (unsigned)(G - 32)) { __builtin_amdgcn_s_sleep(2); if (++sp > (1u << 22)) break; } __builtin_amdgcn_fence(__ATOMIC_ACQUIRE, "agent"); VM_WAIT(); } __syncthreads(); }
                    PMARK(1); scan2::run(F, args, l, bid); PMARK(2); }
#else
            if (bid < 32) {}
#endif
#ifndef NO_NSA
            {
                unsigned* ccnt = (unsigned*)(F.ws + WS_CTL) + CW_CMP + 64 * l;
                {
                if (bid < 32) {}
                else if (bid < 64) {
                    { pg8::Gemm g{(const bf16_t*)(F.ws + WS_Z + Z_KV6), (bf16_t*)(F.ws + WS_W) + W_C1 / 2 + (size_t)l * 512 * 2048, 1024, 2048, nullptr, nullptr}; pg8::RowOrder S{32, 16, 32, bid - 32};
                      epi::Cmp1 E{(bf16_t*)(F.ws + WS_Z + Z_HC), (const float*)(F.ws + WS_TAB + TB_CB) + l * 512};
                      pg8::gemm_phase(F.lds, F.tid, F.ws, g, S, E); }
                    VM_WAIT(); __syncthreads(); __builtin_amdgcn_fence(__ATOMIC_ACQUIRE, "agent"); VM_WAIT(); __syncthreads();
                    { pg8::Gemm g{(const bf16_t*)(F.ws + WS_Z + Z_HC), (bf16_t*)(F.ws + WS_W) + W_C2 / 2 + (size_t)l * 512 * 256, 256, 256, nullptr, nullptr}; pg8::RowOrder S{32, 16, 32, bid - 32};
                      epi::Cmp2 E{(bf16_t*)(F.ws + WS_Z + Z_KCMP), (bf16_t*)(F.ws + WS_Z + Z_VCMPT)};
                      pg8::gemm_phase(F.lds, F.tid, F.ws, g, S, E); }
                    VM_WAIT(); __syncthreads();
                    if (F.tid == 0) { __builtin_amdgcn_fence(__ATOMIC_RELEASE, "agent"); VM_WAIT(); __hip_atomic_fetch_add(ccnt, 1u, RLX_AGENT); }
                } else if (l == 0) convert_set<1>(F, 64, G - 64);
                else convert_set<2>(F, 64, G - 64);
                if (F.tid == 0) { unsigned sp = 0u; while (__hip_atomic_load(ccnt, RLX_AGENT) < 32u) { __builtin_amdgcn_s_sleep(2); if (++sp > (1u << 22)) break; } __builtin_amdgcn_fence(__ATOMIC_ACQUIRE, "agent"); VM_WAIT(); }
                __syncthreads();
                }
                    PMARK(3); nsa_build_bias(F, args);
                {
                    unsigned* qh = (unsigned*)(F.ws + WS_CTL) + CW_NSAQ + 64 * l; volatile LAS unsigned* qslot = (volatile LAS unsigned*)(F.lds + LDSCTL_OFF + 256);
                    const int x0 = (int)(xb_xcc_id() & 7u); int qi = 0;
                    for (;;) {
                        const int slab = (x0 + qi) & 7;
                        if (F.tid == 0) qslot[0] = __hip_atomic_fetch_add(qh + slab, 1u, RLX_AGENT);
                        __syncthreads();
                        const int id = (int)__builtin_amdgcn_readfirstlane(qslot[0]);
                        __syncthreads();
                        if (id >= 256) { if (++qi == 8) break; continue; }
                        const int tt = 255 - id; nsa_item(F, slab >> 1, slab & 1, tt * 32, (bf16_t*)(F.ws + WS_Z + Z_QB));
                    } }
                __syncthreads(); PMARK(4); }
#endif
            SEAM(pb + 3); PMARK(5);
        }
        if (PHON(5) && IN(pb + 4)) { PH_BEGIN();
            pg8::Gemm g{(bf16_t*)(F.ws + WS_XB), (bf16_t*)(F.ws + WS_W) + W_GT / 2 + (size_t)l * 2048 * 1024, 1024, 1024, nullptr, nullptr}; pg8::GridOrder S; S.init(NTOK, 2048, G, bid);
            epi::Gates E{(bf16_t*)(F.ws + WS_Z + Z_RG), (bf16_t*)(F.ws + WS_Z + Z_G2)};
            pg8::gemm_phase(F.lds, F.tid, F.ws, g, S, E);
            SEAM(pb + 4);
        }
        if (PHON(6) && IN(pb + 5)) { PH_BEGIN();
            pg8::Gemm g{(const bf16_t*)(F.ws + WS_Z + Z_QB), (bf16_t*)(F.ws + WS_W) + W_PN / 2 + (size_t)l * 1024 * 512, 512, 512, (const bf16_t*)(F.ws + WS_Z + Z_ORW), (bf16_t*)(F.ws + WS_W) + W_PR / 2 + (size_t)l * 1024 * 512};
            pg8::PairOrder S; S.g.init(NTOK, 1024, G, bid);
            epi::PairGate E{(const bf16_t*)(F.ws + WS_Z + Z_RG), (bf16_t*)(F.ws + WS_Z + Z_G2)};
            pg8::gemm_phase(F.lds, F.tid, F.ws, g, S, E);
            SEAM(pb + 5);
        }
        if (PHON(7) && IN(pb + 6)) { PH_BEGIN();
            pg8::Gemm g{(const bf16_t*)(F.ws + WS_Z + Z_G2), (bf16_t*)(F.ws + WS_W) + W_OUT / 2 + (size_t)l * 1024 * 1024, 1024, 1024, nullptr, nullptr}; pg8::GridOrder S; S.init(NTOK, 1024, G, bid);
            epi::Resid E{(const bf16_t*)(F.ws + WS_XB), (bf16_t*)(F.ws + WS_Z + Z_RG), 1.f, false};
            pg8::gemm_phase(F.lds, F.tid, F.ws, g, S, E);
            SEAM(pb + 6);
        }
        if (PHON(8) && IN(pb + 7)) { PH_BEGIN(); ln_phase(F, (const bf16_t*)(F.ws + WS_Z + Z_RG), inp(F, I_LN1G) + (size_t)l * DM, inp(F, I_LN1B) + (size_t)l * DM, false); SEAM(pb + 7); }
        if (PHON(9) && IN(pb + 8)) { PH_BEGIN();
            pg8::Gemm g{(bf16_t*)(F.ws + WS_XB), (bf16_t*)(F.ws + WS_W) + W_XQ / 2 + (size_t)l * 512 * 1024, 1024, 1024, nullptr, nullptr}; pg8::GridOrder S; S.init(NTOK, 512, G, bid);
            epi::StoreBf16 E{(bf16_t*)(F.ws + WS_Z + Z_QX), 512, 2, XQSCALE};
            pg8::gemm_phase(F.lds, F.tid, F.ws, g, S, E);
            SEAM(pb + 8);
        }
        if (PHON(10) && IN(pb + 9)) { PH_BEGIN(); for (int k = bid; k < 256; k += G) xattn_lds_item(F, l, (k & 7) * 32 + (k >> 3));        SEAM(pb + 9); }
        if (PHON(11) && IN(pb + 10)) { PH_BEGIN();
            pg8::Gemm g{(const bf16_t*)(F.ws + WS_Z + Z_QX), (bf16_t*)(F.ws + WS_W) + W_XO / 2 + (size_t)l * 1024 * 512, 512, 512, nullptr, nullptr}; pg8::GridOrder S; S.init(NTOK, 1024, G, bid);
            epi::Resid E{(const bf16_t*)(F.ws + WS_XB), (bf16_t*)(F.ws + WS_Z + Z_G2), 1.f, false};
            pg8::gemm_phase(F.lds, F.tid, F.ws, g, S, E);
            SEAM(pb + 10);
        }
        if (PHON(12) && IN(pb + 11)) { PH_BEGIN(); ln2_route_phase(F, args, l, (const bf16_t*)(F.ws + WS_Z + Z_G2), false); SEAM(pb + 11); }
        if (PHON(14) && IN(pb + 13)) { PH_BEGIN();
            moe_tables(F, l, PE);
            pg8::Gemm g{(const bf16_t*)(F.ws + WS_XB), (bf16_t*)(F.ws + WS_W) + W_MGU / 2 + (size_t)l * 16 * 1024 * 1024, 1024, 1024, nullptr, nullptr}; pg8::MoeOrder S{PE, G, bid};
            epi::MoeGU E{(bf16_t*)(F.ws + WS_Z + Z_H)};
            pg8::gemm_phase<epi::MoeGU, pg8::MoeOrder, true>(F.lds, F.tid, F.ws, g, S, E, (const int*)(F.ws + WS_TAB + TB_LIST), PE);
            SEAM(pb + 13);
        }
        if (PHON(15) && IN(pb + 14)) { PH_BEGIN();
            moe_tables(F, l, PE);
            pg8::Gemm g{(const bf16_t*)(F.ws + WS_Z + Z_H), (bf16_t*)(F.ws + WS_W) + W_MD / 2 + (size_t)l * 16 * 1024 * 512, 512, 512, nullptr, nullptr}; pg8::MoeOrder S{PE, G, bid};
            epi::StoreBf16 E{(bf16_t*)(F.ws + WS_Z + Z_XS), 1024, 4, 1.f};
            pg8::gemm_phase(F.lds, F.tid, F.ws, g, S, E);
            SEAM(pb + 14);
        }
        if (PHON(16) && IN(pb + 15)) { PH_BEGIN();
            ln3_phase(F, args, l, X, l + 1 == NLAYER, l + 1 < NLAYER);
            SEAM(pb + 15);
        }
        return false;
}

__global__ void __launch_bounds__(512, 2) fwd_kernel(Args args) {
    extern __shared__ __attribute__((aligned(16))) unsigned char lds_raw[];
    Frame F;
    F.lds = (LAS unsigned char*)lds_raw; F.tid = threadIdx.x; F.lane = F.tid & 63; F.wave = __builtin_amdgcn_readfirstlane(F.tid >> 6); F.G = gridDim.x; F.bid = blockIdx.x; F.ws = as_global(args.ws);
    for (int u = F.tid; u < (LDS_BYTES - LDSCTL_OFF) / 4; u += 512) ((LAS unsigned*)(F.lds + LDSCTL_OFF))[u] = 0u;
    __syncthreads();
    if (F.tid < 84) ((LAS unsigned*)(F.lds + PT_OFF))[F.tid] = ((const unsigned __attribute__((address_space(4)))*)__builtin_amdgcn_kernarg_segment_ptr())[F.tid];
    __syncthreads();
    volatile LAS unsigned* MISC = (volatile LAS unsigned*)(F.lds + MISC_OFF);
    XcdBarrier bar; bar.bar = (unsigned*)(F.ws + WS_CTL) + CW_BAR; bar.x = 0; bar.st = nullptr;
    if (!MK_SPLIT) bar = xcd_barrier_post((unsigned*)(F.ws + WS_CTL) + CW_BAR, MISC + 8);
#if MK_SPLIT
    const int lo = args.ph_lo, hi = args.ph_hi;
#endif
    float* X = args.out;
    LAS int* PE = (LAS int*)(F.lds + LDSCTL_OFF);
    const int G = F.G, bid = F.bid;

    unsigned long long probe_prev = (PROBE_ID >= 0) ? __builtin_amdgcn_s_memrealtime() : 0ull, probe_dt = 0ull;
    if (PHON(0) && IN(0)) { prologue(F, args); SEAM(0); GACC(45); }

    if (layer_body<0>(F, args, X, bar, PE, G, bid, probe_prev, probe_dt)) return;
    if (layer_body<1>(F, args, X, bar, PE, G, bid, probe_prev, probe_dt)) return;
    if (PROBE2_A >= 0 && bid == PROBE_WG && F.tid == 0) { const unsigned long long d_ = ((volatile LAS unsigned long long*)(F.lds + LDSCTL_OFF + 512))[1]; const unsigned long long t0_ = __builtin_amdgcn_s_memrealtime(); const unsigned long long w_ = d_ * 9ull < 4000000ull ? d_ * 9ull : 4000000ull; while (__builtin_amdgcn_s_memrealtime() - t0_ < w_) __builtin_amdgcn_s_sleep(8); }
    if (PROBE_ID >= 0 && bid == 0 && F.tid == 0) { const unsigned long long t0_ = __builtin_amdgcn_s_memrealtime(); const unsigned long long w_ = probe_dt * 9ull < 4000000ull ? probe_dt * 9ull : 4000000ull; while (__builtin_amdgcn_s_memrealtime() - t0_ < w_) __builtin_amdgcn_s_sleep(8); }
#undef IN
#undef SEAM
}

extern "C" void kernel_launch(void* const* d_in, const int* in_sizes, int n_in, void* d_out, int out_size, void* d_ws, size_t ws_size, hipStream_t stream) {
    static int grid = 0;
    if (grid == 0) {
        if (n_in != 42 || out_size != NTOK * DM || ws_size < WS_END) { fprintf(stderr, "kernel_launch: unexpected problem (n_in %d, out %d, ws %zu < %zu)\n", n_in, out_size, ws_size, (size_t)WS_END); grid = -1; return; }
        int dev = 0, cus = 0, per_cu = 0;
        if (hipGetDevice(&dev) != hipSuccess || hipDeviceGetAttribute(&cus, hipDeviceAttributeMultiprocessorCount, dev) != hipSuccess) { grid = -1; return; }
        if (hipFuncSetAttribute((const void*)fwd_kernel, hipFuncAttributeMaxDynamicSharedMemorySize, LDS_BYTES) != hipSuccess) { fprintf(stderr, "kernel_launch: hipFuncSetAttribute failed\n"); grid = -1; return; }
        if (hipOccupancyMaxActiveBlocksPerMultiprocessor(&per_cu, (const void*)fwd_kernel, 512, LDS_BYTES) != hipSuccess || per_cu < 1) fprintf(stderr, "kernel_launch: occupancy query says %d\n", per_cu);
        (void)hipGetLastError();
        grid = cus;
        if (grid < 96 || (grid % 8) != 0) { fprintf(stderr, "kernel_launch: unsupported CU count %d\n", cus); grid = -1; return; }
    }
    if (grid < 0) return;
    (void)hipMemsetAsync((char*)d_ws + WS_CTL, 0, CTL_ZERO_BYTES, stream);
    Args a{};
    for (int i = 0; i < 42; ++i) a.in[i] = (const float*)d_in[i];
    a.out = (float*)d_out; a.ws = (unsigned char*)d_ws;
#if MK_SPLIT
    for (int p = 0; p < N_PHASES; ++p) { a.ph_lo = p; a.ph_hi = p + 1; hipLaunchKernelGGL(fwd_kernel, dim3(grid), dim3(512), LDS_BYTES, stream, a); }
#else
    a.ph_lo = 0; a.ph_hi = N_PHASES;
    hipLaunchKernelGGL(fwd_kernel, dim3(grid), dim3(512), LDS_BYTES, stream, a);
#endif
}
```
